# Optimizing an MI355X kernel written in HIP

```python
import math
import jax, jax.numpy as jnp
from jax import lax
import numpy as np

D_MODEL = 1024
BATCH = 8
SEQ = 4096
DEPTH = 1

HEAD_DIM = 64
N_ATTN_HEADS = 8
N_KV_HEADS = 2
KV_GROUP = N_ATTN_HEADS // N_KV_HEADS
N_RWKV_HEADS = 8
ATTN_WIDTH = N_ATTN_HEADS * HEAD_DIM
KV_WIDTH = N_KV_HEADS * HEAD_DIM
RWKV_WIDTH = N_RWKV_HEADS * HEAD_DIM
D_MIX = ATTN_WIDTH + RWKV_WIDTH
WINDOW = 128
ATTN_BLOCK = 128
ROT_DIM = HEAD_DIM // 4
ROPE_THETA = 500000.0
DECAY_LORA = 32
AAA_LORA = 32
GATE_LORA = 96
N_EXPERTS = 32
TOP_K = 4
D_FF = D_MODEL
SWIGLU_LIMIT = 7.0
SWIGLU_ALPHA = 1.702
MOE_BLOCK = 256
LN_EPS = 1e-5
RWKV_GN_EPS = 64e-5
NEG_INF = -1e30
DEEPNORM_ALPHA = (2 * DEPTH) ** 0.25
DEEPNORM_BETA = (8 * DEPTH) ** -0.25

IN_SIZES = (ATTN_WIDTH, KV_WIDTH, KV_WIDTH,
            RWKV_WIDTH, RWKV_WIDTH, RWKV_WIDTH,
            DECAY_LORA, AAA_LORA, GATE_LORA)
D_IN = sum(IN_SIZES)
ATTN_IN = ATTN_WIDTH + 2 * KV_WIDTH
RWKV_IN = D_IN - ATTN_IN

kernel_name = "hybrid_swa_rwkv7_moe_deepnorm_adaln"


def _layer_norm(x, g=None, b=None):
    xf = x.astype(jnp.float32)
    mu = jnp.mean(xf, axis=-1, keepdims=True)
    var = jnp.mean(jnp.square(xf - mu), axis=-1, keepdims=True)
    y = (xf - mu) * lax.rsqrt(var + LN_EPS)
    if g is not None:
        y = y * g.astype(jnp.float32) + b.astype(jnp.float32)
    return y.astype(x.dtype)


def _partial_rotary(t, positions):
    inv_freq = ROPE_THETA ** (-jnp.arange(0, ROT_DIM, 2, dtype=jnp.float32) / ROT_DIM)
    ang = positions.astype(jnp.float32)[..., None] * inv_freq
    cos, sin = jnp.cos(ang)[:, :, None, :], jnp.sin(ang)[:, :, None, :]
    tr = t[..., :ROT_DIM].astype(jnp.float32)
    t1, t2 = tr[..., :ROT_DIM // 2], tr[..., ROT_DIM // 2:]
    rot = jnp.concatenate([t1 * cos - t2 * sin, t2 * cos + t1 * sin], axis=-1).astype(t.dtype)
    return jnp.concatenate([rot, t[..., ROT_DIM:]], axis=-1)


def _sliding_window_attention(q, k, v, sinks):
    B, S = q.shape[0], q.shape[1]
    nb = S // ATTN_BLOCK
    qb = q.reshape(B, nb, ATTN_BLOCK, N_KV_HEADS, KV_GROUP, HEAD_DIM).astype(jnp.float32)

    def band(t):
        tp = jnp.pad(t, ((0, 0), (ATTN_BLOCK, 0), (0, 0), (0, 0)))
        tb = tp.reshape(B, nb + 1, ATTN_BLOCK, N_KV_HEADS, HEAD_DIM)
        return jnp.concatenate([tb[:, :-1], tb[:, 1:]], axis=2).astype(jnp.float32)

    kb, vb = band(k), band(v)
    s = jnp.einsum("bnqhgd,bnkhd->bhgnqk", qb, kb) / math.sqrt(HEAD_DIM)
    qi = jnp.arange(ATTN_BLOCK)[:, None]
    kj = jnp.arange(2 * ATTN_BLOCK)[None, :]
    rel = qi + ATTN_BLOCK - kj
    key_pos = jnp.arange(nb)[:, None, None] * ATTN_BLOCK - ATTN_BLOCK + kj[None]
    allowed = (rel >= 0) & (rel < WINDOW) & (key_pos >= 0)
    s = jnp.where(allowed, s, NEG_INF)
    sink = sinks.astype(jnp.float32).reshape(N_KV_HEADS, KV_GROUP)[None, :, :, None, None, None]
    m = jnp.maximum(jnp.max(s, axis=-1, keepdims=True), sink)
    p = jnp.exp(s - m)
    denom = jnp.sum(p, axis=-1, keepdims=True) + jnp.exp(sink - m)
    o = jnp.einsum("bhgnqk,bnkhd->bnqhgd", p / denom, vb)
    return o.reshape(B, S, ATTN_WIDTH).astype(q.dtype)


def _rwkv7_time_mix(r, k, v, wl, al, gl, w0, w2, a0, a2, g2, k_k, k_a, r_k, ln_w, ln_b):
    B, S, _ = r.shape
    heads = lambda t: t.reshape(B, S, N_RWKV_HEADS, HEAD_DIM)
    w = -jax.nn.softplus(-(w0 + jnp.tanh(wl) @ w2)) - 0.5
    decay = jnp.exp(-jnp.exp(w.astype(jnp.float32)))
    a = jax.nn.sigmoid(a0 + al @ a2)
    g = jax.nn.sigmoid(gl) @ g2
    kk = heads(k * k_k).astype(jnp.float32)
    kk = kk / jnp.maximum(jnp.sqrt(jnp.sum(kk * kk, axis=-1, keepdims=True)), 1e-12)
    k = k * (1.0 + (a - 1.0) * k_a)
    a_h = heads(a).astype(jnp.float32)

    to_time = lambda t: jnp.moveaxis(t.astype(jnp.float32), 1, 0)
    xs = (to_time(heads(r)), to_time(heads(decay)), to_time(heads(k)), to_time(heads(v)),
          to_time(-kk), to_time(kk * a_h))

    def step(state, inp):
        r_t, w_t, k_t, v_t, a_t, b_t = inp
        sa = jnp.einsum("bhvk,bhk->bhv", state, a_t)
        state = (state * w_t[:, :, None, :] + sa[..., None] * b_t[:, :, None, :]
                 + v_t[..., None] * k_t[:, :, None, :])
        return state, jnp.einsum("bhvk,bhk->bhv", state, r_t)

    s0 = jnp.zeros((B, N_RWKV_HEADS, HEAD_DIM, HEAD_DIM), jnp.float32)
    _, ys = lax.scan(step, s0, xs)
    y = jnp.moveaxis(ys, 0, 1)
    mu = jnp.mean(y, axis=-1, keepdims=True)
    var = jnp.mean(jnp.square(y - mu), axis=-1, keepdims=True)
    y = ((y - mu) * lax.rsqrt(var + RWKV_GN_EPS)).reshape(B, S, RWKV_WIDTH)
    y = y * ln_w.astype(jnp.float32) + ln_b.astype(jnp.float32)
    bonus = jnp.sum(heads(r * k).astype(jnp.float32) * r_k.astype(jnp.float32), axis=-1, keepdims=True)
    y = y + (bonus * heads(v).astype(jnp.float32)).reshape(B, S, RWKV_WIDTH)
    return (y * g.astype(jnp.float32)).astype(r.dtype)


def _moe(h, w_router, b_router, w_gate_up, b_gate_up, w_down, b_down):
    T = h.shape[0]
    n_assign = T * TOP_K
    logits = (h @ w_router + b_router).astype(jnp.float32)
    top_v, top_i = lax.top_k(logits, TOP_K)
    gates = jax.nn.softmax(top_v, axis=-1).astype(h.dtype)
    flat_e = top_i.reshape(n_assign).astype(jnp.int32)
    flat_g = gates.reshape(n_assign)
    flat_tok = jnp.arange(n_assign, dtype=jnp.int32) // TOP_K
    order = jnp.argsort(flat_e)
    se, stok, sg = flat_e[order], flat_tok[order], flat_g[order]
    counts = jax.ops.segment_sum(jnp.ones_like(flat_e), flat_e, num_segments=N_EXPERTS)
    padded = (counts + MOE_BLOCK - 1) // MOE_BLOCK * MOE_BLOCK
    start = jnp.cumsum(counts) - counts
    pend = jnp.cumsum(padded)
    pstart = pend - padded
    dest = pstart[se] + (jnp.arange(n_assign, dtype=jnp.int32) - start[se])
    n_blocks = n_assign // MOE_BLOCK + N_EXPERTS
    tok_buf = jnp.zeros((n_blocks * MOE_BLOCK,), jnp.int32).at[dest].set(stok)
    g_buf = jnp.zeros((n_blocks * MOE_BLOCK,), h.dtype).at[dest].set(sg)
    blk_e = jnp.clip(jnp.searchsorted(pend, jnp.arange(n_blocks, dtype=jnp.int32) * MOE_BLOCK,
                                      side="right"), 0, N_EXPERTS - 1).astype(jnp.int32)

    def body(out, blk):
        tok, gw, e = blk
        xb = h[tok]
        gu = xb @ w_gate_up[e] + b_gate_up[e]
        gate = jnp.minimum(gu[:, :D_FF], SWIGLU_LIMIT)
        up = jnp.clip(gu[:, D_FF:], -SWIGLU_LIMIT, SWIGLU_LIMIT)
        act = (up + 1.0) * (gate * jax.nn.sigmoid(SWIGLU_ALPHA * gate))
        yb = act @ w_down[e] + b_down[e]
        return out.at[tok].add(yb * gw[:, None]), None

    out, _ = lax.scan(body, jnp.zeros_like(h),
                      (tok_buf.reshape(n_blocks, MOE_BLOCK), g_buf.reshape(n_blocks, MOE_BLOCK), blk_e))
    return out


def _hybrid_layer(x, c, positions, w_ada, b_ada, w_in, shift_mu, rwkv_w0, rwkv_w2, rwkv_a0,
                  rwkv_a2, rwkv_g2, rwkv_k_k, rwkv_k_a, rwkv_r_k, rwkv_ln_w, rwkv_ln_b,
                  attn_sinks, w_out, ln1_g, ln1_b, w_router, b_router, w_gate_up, b_gate_up,
                  w_down, b_down, ln2_g, ln2_b):
    B, S, D = x.shape
    mod = (jax.nn.silu(c) @ w_ada + b_ada)[:, None, :]
    shift1, scale1, gate1, shift2, scale2, gate2 = jnp.split(mod, 6, axis=-1)

    h = _layer_norm(x) * (1.0 + scale1) + shift1
    proj = h @ w_in
    q, ka, va = jnp.split(proj[..., :ATTN_IN], [ATTN_WIDTH, ATTN_WIDTH + KV_WIDTH], axis=-1)
    rw = proj[..., ATTN_IN:]
    rw_prev = jnp.pad(rw, ((0, 0), (1, 0), (0, 0)))[:, :-1]
    rw = rw + (rw_prev - rw) * shift_mu
    r, kr, vr, wl, al, gl = jnp.split(
        rw, list(np.cumsum([RWKV_WIDTH, RWKV_WIDTH, RWKV_WIDTH, DECAY_LORA, AAA_LORA])), axis=-1)

    q = _partial_rotary(q.reshape(B, S, N_ATTN_HEADS, HEAD_DIM), positions)
    ka = _partial_rotary(ka.reshape(B, S, N_KV_HEADS, HEAD_DIM), positions)
    va = va.reshape(B, S, N_KV_HEADS, HEAD_DIM)
    attn_out = _sliding_window_attention(q, ka, va, attn_sinks)
    rwkv_out = _rwkv7_time_mix(r, kr, vr, wl, al, gl, rwkv_w0, rwkv_w2, rwkv_a0, rwkv_a2,
                               rwkv_g2, rwkv_k_k, rwkv_k_a, rwkv_r_k, rwkv_ln_w, rwkv_ln_b)
    y = jnp.concatenate([attn_out, rwkv_out], axis=-1) @ w_out
    x = _layer_norm(DEEPNORM_ALPHA * x + (1.0 + gate1) * y, ln1_g, ln1_b)

    h = _layer_norm(x) * (1.0 + scale2) + shift2
    y = _moe(h.reshape(B * S, D), w_router, b_router, w_gate_up, b_gate_up,
             w_down, b_down).reshape(B, S, D)
    return _layer_norm(DEEPNORM_ALPHA * x + (1.0 + gate2) * y, ln2_g, ln2_b)


def setup_inputs(seed: int = 0) -> dict:
    key = jax.random.key(seed)
    ks = jax.random.split(key, 32)
    L = DEPTH
    f32 = jnp.float32
    nrm = lambda k, shape, scale: jax.random.normal(k, shape, f32) * scale
    x = nrm(ks[0], (BATCH, SEQ, D_MODEL), 1.0)
    c = nrm(ks[1], (BATCH, D_MODEL), 1.0)
    positions = (jax.random.randint(ks[2], (BATCH, 1), 0, 4096, dtype=jnp.int32)
                 + jnp.arange(SEQ, dtype=jnp.int32)[None, :])
    w_ada = nrm(ks[3], (L, D_MODEL, 6 * D_MODEL), 0.1 * D_MODEL ** -0.5)
    b_ada = nrm(ks[4], (L, 6 * D_MODEL), 0.01)
    v_cols = (2, 5)
    col_scale = jnp.concatenate([jnp.full((n,), DEEPNORM_BETA if i in v_cols else 1.0, f32)
                                 for i, n in enumerate(IN_SIZES)])
    w_in = nrm(ks[5], (L, D_MODEL, D_IN), D_MODEL ** -0.5) * col_scale
    shift_mu = jax.random.uniform(ks[6], (L, RWKV_IN), f32)
    rwkv_w0 = jax.random.uniform(ks[7], (L, RWKV_WIDTH), f32, minval=-6.0, maxval=1.0)
    rwkv_w2 = nrm(ks[8], (L, DECAY_LORA, RWKV_WIDTH), 0.1 * DECAY_LORA ** -0.5)
    rwkv_a0 = nrm(ks[9], (L, RWKV_WIDTH), 0.5)
    rwkv_a2 = nrm(ks[10], (L, AAA_LORA, RWKV_WIDTH), AAA_LORA ** -0.5)
    rwkv_g2 = nrm(ks[11], (L, GATE_LORA, RWKV_WIDTH), GATE_LORA ** -0.5)
    rwkv_k_k = 0.85 + nrm(ks[12], (L, RWKV_WIDTH), 0.05)
    rwkv_k_a = 1.0 + nrm(ks[13], (L, RWKV_WIDTH), 0.05)
    rwkv_r_k = nrm(ks[14], (L, N_RWKV_HEADS, HEAD_DIM), 0.1)
    rwkv_ln_w = 1.0 + nrm(ks[15], (L, RWKV_WIDTH), 0.05)
    rwkv_ln_b = nrm(ks[16], (L, RWKV_WIDTH), 0.01)
    attn_sinks = nrm(ks[17], (L, N_ATTN_HEADS), 0.5)
    w_out = nrm(ks[18], (L, D_MIX, D_MODEL), D_MIX ** -0.5 * DEEPNORM_BETA)
    ln1_g = 1.0 + nrm(ks[19], (L, D_MODEL), 0.05)
    ln1_b = nrm(ks[20], (L, D_MODEL), 0.01)
    w_router = nrm(ks[21], (L, D_MODEL, N_EXPERTS), D_MODEL ** -0.5)
    b_router = nrm(ks[22], (L, N_EXPERTS), 0.01)
    w_gate_up = nrm(ks[23], (L, N_EXPERTS, D_MODEL, 2 * D_FF), D_MODEL ** -0.5 * DEEPNORM_BETA)
    b_gate_up = nrm(ks[24], (L, N_EXPERTS, 2 * D_FF), 0.01)
    w_down = nrm(ks[25], (L, N_EXPERTS, D_FF, D_MODEL), D_FF ** -0.5 * DEEPNORM_BETA)
    b_down = nrm(ks[26], (L, N_EXPERTS, D_MODEL), 0.01)
    ln2_g = 1.0 + nrm(ks[27], (L, D_MODEL), 0.05)
    ln2_b = nrm(ks[28], (L, D_MODEL), 0.01)
    return {"x": x, "c": c, "positions": positions, "w_ada": w_ada, "b_ada": b_ada,
            "w_in": w_in, "shift_mu": shift_mu, "rwkv_w0": rwkv_w0, "rwkv_w2": rwkv_w2,
            "rwkv_a0": rwkv_a0, "rwkv_a2": rwkv_a2, "rwkv_g2": rwkv_g2, "rwkv_k_k": rwkv_k_k,
            "rwkv_k_a": rwkv_k_a, "rwkv_r_k": rwkv_r_k, "rwkv_ln_w": rwkv_ln_w,
            "rwkv_ln_b": rwkv_ln_b, "attn_sinks": attn_sinks, "w_out": w_out,
            "ln1_g": ln1_g, "ln1_b": ln1_b, "w_router": w_router, "b_router": b_router,
            "w_gate_up": w_gate_up, "b_gate_up": b_gate_up, "w_down": w_down,
            "b_down": b_down, "ln2_g": ln2_g, "ln2_b": ln2_b}


def reference(x, c, positions, w_ada, b_ada, w_in, shift_mu, rwkv_w0, rwkv_w2, rwkv_a0,
              rwkv_a2, rwkv_g2, rwkv_k_k, rwkv_k_a, rwkv_r_k, rwkv_ln_w, rwkv_ln_b,
              attn_sinks, w_out, ln1_g, ln1_b, w_router, b_router, w_gate_up, b_gate_up,
              w_down, b_down, ln2_g, ln2_b):
    for l in range(DEPTH):
        x = _hybrid_layer(x, c, positions, w_ada[l], b_ada[l], w_in[l], shift_mu[l],
                          rwkv_w0[l], rwkv_w2[l], rwkv_a0[l], rwkv_a2[l], rwkv_g2[l],
                          rwkv_k_k[l], rwkv_k_a[l], rwkv_r_k[l], rwkv_ln_w[l], rwkv_ln_b[l],
                          attn_sinks[l], w_out[l], ln1_g[l], ln1_b[l], w_router[l],
                          b_router[l], w_gate_up[l], b_gate_up[l], w_down[l], b_down[l],
                          ln2_g[l], ln2_b[l])
    return x
```

```cpp
#include <hip/hip_runtime.h>
#include <cstdio>
#include <cstdint>

#ifndef MK_PER_PHASE
#define MK_PER_PHASE 0
#endif

namespace pg8 {
#define PG8_LAS __attribute__((address_space(3)))
typedef unsigned short bf16_t;
typedef short bf16x8 __attribute__((ext_vector_type(8)));
typedef float f32x4 __attribute__((ext_vector_type(4)));
typedef unsigned u32x4 __attribute__((ext_vector_type(4)));
constexpr int BM = 256, BK = 64, HALF = 128, HTB = HALF * BK * 2  , STAGE_BYTES = 8 * HTB, NXCD = 8, WGM = 8;

__host__ __device__ __forceinline__ int lds_byte(int r, int c) { const int st = (r >> 4) * 2 + (c >> 5), rr = r & 15, cc = c & 31, ob = rr * 64 + cc * 2; return st * 1024 + (ob ^ (((ob >> 9) & 1) << 5)); }
__host__ __device__ __forceinline__ void stage_rc(int b, int& R, int& C) { const int st = b / 1024, sb = b % 1024, swz = sb ^ (((sb >> 9) & 1) << 5); R = (st >> 1) * 16 + swz / 64; C = (st & 1) * 32 + (swz % 64) / 2; }
__host__ __device__ __forceinline__ int perm32(int rho) { const int n = rho >> 4, i = rho & 15; return 8 * (i >> 2) + 4 * n + (i & 3); }

struct Unit { int pm, pn, e; };
struct Gemm { const bf16_t* A; const bf16_t* Bt; int K; size_t estride; int scale_a, scale_b, dry; const PG8_LAS unsigned short* toklist; };
typedef int v8i_t __attribute__((ext_vector_type(8)));
typedef v8i_t v8i_a16 __attribute__((aligned(16)));
__device__ __forceinline__ v8i_t cat8(bf16x8 lo, bf16x8 hi) { typedef int v4i_t __attribute__((ext_vector_type(4))); const v4i_t a = __builtin_bit_cast(v4i_t, lo), b = __builtin_bit_cast(v4i_t, hi); return (v8i_t){a[0], a[1], a[2], a[3], b[0], b[1], b[2], b[3]}; }

struct StaticOrder {
    int nM, nN, nwg, G, c;
    __device__ void init(int M, int N, int G_, int c_) { nM = M / BM; nN = N / BM; nwg = nM * nN; G = G_; c = c_; }
    __device__ bool next(int i, Unit& u) const {
        const long L = (long)i * G + c; if (L >= nwg) return false;
        int wgid = (int)L; { const int q = nwg / NXCD, r = nwg % NXCD, xcd = wgid % NXCD, off = wgid / NXCD; wgid = (xcd < r ? xcd * (q + 1) : r * (q + 1) + (xcd - r) * q) + off; }
        const int nig = WGM * nN, gid = wgid / nig, fm = gid * WGM, gsz = (nM - fm) < WGM ? (nM - fm) : WGM;
        u.pm = fm + ((wgid % nig) % gsz); u.pn = (wgid % nig) / gsz; u.e = 0; return true;
    }
    __device__ __forceinline__ void a_ready(const Unit&) const {}
    __device__ __forceinline__ void done(const Unit&) const {}
};
struct MoeOrder {
    const PG8_LAS int* ts; int NT, G, c;
    __device__ bool next(int i, Unit& u) const {
        const int L = i * G + c; const int ntl = ts[32];
        if (L >= ntl * NT) return false;
        const int tau = L / NT; u.pm = tau; u.pn = L - tau * NT; int e = 0;
#pragma unroll 1
        for (int j = 1; j < 32; ++j) e += (ts[j] <= tau) ? 1 : 0;
        u.e = e; return true;
    }
    __device__ __forceinline__ void a_ready(const Unit&) const {}
    __device__ __forceinline__ void done(const Unit&) const {}
};

typedef __bf16 bf16x2_t __attribute__((ext_vector_type(2)));
__device__ __forceinline__ unsigned cvt_pk_bf16(float lo, float hi) { const bf16x2_t v = {(__bf16)lo, (__bf16)hi}; return __builtin_bit_cast(unsigned, v); }

struct EpiF32 {
    static constexpr bool PERM = false, AFTER_DRAIN = false;
    __device__ __forceinline__ f32x4 init(const Unit&, int, int, int, int) const { return (f32x4){0.f, 0.f, 0.f, 0.f}; }
    float* C; int ldc;
    __device__ __forceinline__ void operator()(const f32x4 (&acc)[2][2][4][2], const Unit& u, int wr, int wc, int fr, int fq) const {
        const int row0 = u.pm * BM + wr * 64 + fr, col0 = u.pn * BM + wc * 32 + 4 * fq;
#pragma unroll
        for (int ai = 0; ai < 2; ++ai)
#pragma unroll
            for (int m = 0; m < 4; ++m) { float* rowp = C + (size_t)(row0 + ai * HALF + m * 16) * ldc + col0;
#pragma unroll
                for (int bj = 0; bj < 2; ++bj)
#pragma unroll
                    for (int n = 0; n < 2; ++n) *(f32x4*)(rowp + bj * HALF + n * 16) = acc[ai][bj][m][n]; }
    }
};
struct EpiBf16 {
    static constexpr bool PERM = true, AFTER_DRAIN = false;
    __device__ __forceinline__ f32x4 init(const Unit&, int, int, int, int) const { return (f32x4){0.f, 0.f, 0.f, 0.f}; }
    bf16_t* O; int ldc; const float* bias; int bstride;
    __device__ __forceinline__ void operator()(const f32x4 (&acc)[2][2][4][2], const Unit& u, int wr, int wc, int fr, int fq) const {
        const int row0 = u.pm * BM + wr * 64 + fr; const int col0 = u.pn * BM + wc * 32 + 8 * fq;
        f32x4 bv[2][2];
#pragma unroll
        for (int bj = 0; bj < 2; ++bj)
#pragma unroll
            for (int n = 0; n < 2; ++n) bv[bj][n] = bias ? *(const f32x4*)(bias + (size_t)u.e * bstride + col0 + bj * HALF + 4 * n) : (f32x4){0.f, 0.f, 0.f, 0.f};
#pragma unroll
        for (int ai = 0; ai < 2; ++ai)
#pragma unroll
            for (int m = 0; m < 4; ++m) { bf16_t* rowp = O + (size_t)(row0 + ai * HALF + m * 16) * ldc + col0;
#pragma unroll
                for (int bj = 0; bj < 2; ++bj) { const f32x4 v0 = acc[ai][bj][m][0] + bv[bj][0], v1 = acc[ai][bj][m][1] + bv[bj][1];
                    u32x4 w; w.x = cvt_pk_bf16(v0[0], v0[1]); w.y = cvt_pk_bf16(v0[2], v0[3]); w.z = cvt_pk_bf16(v1[0], v1[1]); w.w = cvt_pk_bf16(v1[2], v1[3]);
                    *(u32x4*)(rowp + bj * HALF) = w; } }
    }
};
__device__ __forceinline__ unsigned pk4_fp8(float a, float b, float c, float d) { int w = 0; w = __builtin_amdgcn_cvt_pk_fp8_f32(a, b, w, false); w = __builtin_amdgcn_cvt_pk_fp8_f32(c, d, w, true); return (unsigned)w; }
struct EpiScatter {
    static constexpr bool PERM = true, AFTER_DRAIN = false;
    __device__ __forceinline__ f32x4 init(const Unit& u, int bj, int n, int wc, int fq) const { return *(const f32x4*)(bias + (size_t)u.e * 1024 + u.pn * BM + wc * 32 + 8 * fq + bj * HALF + 4 * n); }
    unsigned char* O; const float* bias; const int* map;
    __device__ __forceinline__ void operator()(const f32x4 (&acc)[2][2][4][2], const Unit& u, int wr, int wc, int fr, int fq) const {
        const int row0 = u.pm * BM + wr * 64 + fr; const int col0 = u.pn * BM + wc * 32 + 8 * fq;
        int dst[2][4];
#pragma unroll
        for (int ai = 0; ai < 2; ++ai)
#pragma unroll
            for (int m = 0; m < 4; ++m) dst[ai][m] = map[row0 + ai * HALF + m * 16];
        typedef unsigned u32x2 __attribute__((ext_vector_type(2)));
#pragma unroll
        for (int ai = 0; ai < 2; ++ai)
#pragma unroll
            for (int m = 0; m < 4; ++m) { if (dst[ai][m] < 0) continue; unsigned char* rowp = O + (size_t)dst[ai][m] * 1024 + col0;
#pragma unroll
                for (int bj = 0; bj < 2; ++bj) { const f32x4 v0 = acc[ai][bj][m][0] * 16.0f, v1 = acc[ai][bj][m][1] * 16.0f;
                    *(u32x2*)(rowp + bj * HALF) = (u32x2){pk4_fp8(v0[0], v0[1], v0[2], v0[3]), pk4_fp8(v1[0], v1[1], v1[2], v1[3])}; } }
    }
};
struct EpiSwiglu {
    static constexpr bool PERM = true, AFTER_DRAIN = false;
    __device__ __forceinline__ f32x4 init(const Unit&, int, int, int, int) const { return (f32x4){0.f, 0.f, 0.f, 0.f}; }
    bf16_t* O; const float* bias;
    __device__ __forceinline__ void operator()(const f32x4 (&acc)[2][2][4][2], const Unit& u, int wr, int wc, int fr, int fq) const {
        const int row0 = u.pm * BM + wr * 64 + fr; const int c0 = u.pn * HALF + wc * 32 + 8 * fq;
        f32x4 bg[2], bu[2];
#pragma unroll
        for (int n = 0; n < 2; ++n) { bg[n] = *(const f32x4*)(bias + (size_t)u.e * 2048 + c0 + 4 * n); bu[n] = *(const f32x4*)(bias + (size_t)u.e * 2048 + 1024 + c0 + 4 * n); }
#pragma unroll
        for (int ai = 0; ai < 2; ++ai)
#pragma unroll
            for (int m = 0; m < 4; ++m) { bf16_t* rowp = O + (size_t)(row0 + ai * HALF + m * 16) * 1024 + c0;
                float o[8];
#pragma unroll
                for (int n = 0; n < 2; ++n) { const f32x4 g4 = acc[ai][0][m][n] + bg[n], u4 = acc[ai][1][m][n] + bu[n];
#pragma unroll
                    for (int j = 0; j < 4; ++j) { const float g = fminf(g4[j], 7.0f), up = fminf(fmaxf(u4[j], -7.0f), 7.0f);
                        const float sg = __builtin_amdgcn_rcpf(1.0f + __builtin_amdgcn_exp2f(-1.702f * 1.44269504089f * g));
                        o[4 * n + j] = (up + 1.0f) * (g * sg); } }
                u32x4 w; w.x = cvt_pk_bf16(o[0], o[1]); w.y = cvt_pk_bf16(o[2], o[3]); w.z = cvt_pk_bf16(o[4], o[5]); w.w = cvt_pk_bf16(o[6], o[7]);
                *(u32x4*)rowp = w; }
    }
};

struct EpiSwiglu8 {
    static constexpr bool PERM = true, AFTER_DRAIN = false;
    __device__ __forceinline__ f32x4 init(const Unit& u, int bj, int n, int wc, int fq) const { return *(const f32x4*)(bias + (size_t)u.e * 2048 + bj * 1024 + u.pn * HALF + wc * 32 + 8 * fq + 4 * n); }
    unsigned char* O; const float* bias;
    __device__ __forceinline__ void operator()(const f32x4 (&acc)[2][2][4][2], const Unit& u, int wr, int wc, int fr, int fq) const {
        const int row0 = u.pm * BM + wr * 64 + fr; const int c0 = u.pn * HALF + wc * 32 + 8 * fq;
#pragma unroll
        for (int ai = 0; ai < 2; ++ai)
#pragma unroll
            for (int m = 0; m < 4; ++m) { unsigned char* rowp = O + (size_t)(row0 + ai * HALF + m * 16) * 1024 + c0;
                float o[8];
#pragma unroll
                for (int n = 0; n < 2; ++n) { const f32x4 g4 = acc[ai][0][m][n], u4 = acc[ai][1][m][n];
#pragma unroll
                    for (int j = 0; j < 4; ++j) { const float g = fminf(g4[j], 7.0f), up = fminf(fmaxf(u4[j], -7.0f), 7.0f);
                        const float sg = __builtin_amdgcn_rcpf(1.0f + __builtin_amdgcn_exp2f(-1.702f * 1.44269504089f * g));
                        o[4 * n + j] = (up + 1.0f) * (g * sg); } }
                typedef unsigned u32x2 __attribute__((ext_vector_type(2)));
                *(u32x2*)rowp = (u32x2){pk4_fp8(o[0], o[1], o[2], o[3]), pk4_fp8(o[4], o[5], o[6], o[7])}; }
    }
};

template <class Epi, class Sched, bool ALIGN_EPI = false, bool SP2 = false, bool FP8 = false, bool GATHER = false>
__device__ __forceinline__ void gemm_phase(PG8_LAS unsigned char* lds, const Gemm g, const Sched& S, const Epi& E) {
    const int tid = threadIdx.x, wid = __builtin_amdgcn_readfirstlane(tid >> 6), lane = tid & 63, wr = wid >> 2, wc = wid & 3, fr = lane & 15, fq = lane >> 4;
    const int K = g.K, nt = K / BK;
    unsigned vC[2][2], vN[2][2], voffB[2]; int Rr[2], Cb[2];
#pragma unroll
    for (int i = 0; i < 2; ++i) { int R, C; stage_rc(tid * 16 + i * 8192, R, C); const int Rb = Epi::PERM ? ((R & ~31) + perm32(R & 31)) : R; Rr[i] = R; Cb[i] = C * 2;
        voffB[i] = (unsigned)(Rb * K + C) * 2u;
#pragma unroll
        for (int h = 0; h < 2; ++h) { vC[h][i] = (unsigned)((HALF * h + R) * K + C) * 2u; vN[h][i] = vC[h][i]; } }
#define PG8_GOFF(dst, uix) do { if constexpr (GATHER) { _Pragma("unroll") for (int h_ = 0; h_ < 2; ++h_) _Pragma("unroll") for (int i_ = 0; i_ < 2; ++i_) \
        dst[h_][i_] = (unsigned)g.toklist[(uix) * 256 + HALF * h_ + Rr[i_]] * (unsigned)(K * 2) + (unsigned)Cb[i_]; } } while (0)
    const size_t kstep = (size_t)(BK * 2);
    const size_t hstep = (size_t)HALF * K * 2;
    const size_t tstep = 2 * hstep;
    const unsigned ldsw = (unsigned)wid * 1024u;
    constexpr int KSTR = 1024;
    const int aoff = lds_byte(wr * 64 + fr, fq * 8), boff = lds_byte(wc * 32 + fr, fq * 8);
#define PG8_SA(b, h) (((b) * 2 + (h)) * HTB)
#define PG8_SB(b, h) ((4 + (b) * 2 + (h)) * HTB)
#define PG8_STAGE(bufoff, gbase, voff) do { _Pragma("unroll") for (int _i = 0; _i < 2; ++_i) \
        __builtin_amdgcn_global_load_lds((const unsigned*)((const char*)(gbase) + (voff)[_i]), (PG8_LAS unsigned*)(lds + (bufoff) + ldsw + _i * 8192), 16, 0, 0); } while (0)
#define PG8_LDA(dst, b, h) do { _Pragma("unroll") for (int m = 0; m < 4; ++m) _Pragma("unroll") for (int k = 0; k < 2; ++k) dst[m][k] = *(const PG8_LAS bf16x8*)(lds + PG8_SA(b, h) + aoff + m * 2048 + k * KSTR); } while (0)
#define PG8_LDB(dst, b, h) do { _Pragma("unroll") for (int n = 0; n < 2; ++n) _Pragma("unroll") for (int k = 0; k < 2; ++k) dst[n][k] = *(const PG8_LAS bf16x8*)(lds + PG8_SB(b, h) + boff + n * 2048 + k * KSTR); } while (0)
#define PG8_MMA(ai, bj, At, Bt) do { __builtin_amdgcn_s_setprio(1); _Pragma("unroll") for (int m = 0; m < 4; ++m) _Pragma("unroll") for (int n = 0; n < 2; ++n) { \
        if constexpr (FP8) { acc[ai][bj][m][n] = __builtin_amdgcn_mfma_scale_f32_16x16x128_f8f6f4(cat8(Bt[n][0], Bt[n][1]), cat8(At[m][0], At[m][1]), acc[ai][bj][m][n], 0, 0, 0, g.scale_b, 0, g.scale_a); } \
        else { _Pragma("unroll") for (int k = 0; k < 2; ++k) acc[ai][bj][m][n] = __builtin_amdgcn_mfma_f32_16x16x32_bf16(Bt[n][k], At[m][k], acc[ai][bj][m][n], 0, 0, 0); } } \
        if constexpr (FP8) { _Pragma("unroll") for (int m = 0; m < 4; ++m) asm volatile("" : "+v"(acc[ai][bj][m][0]), "+v"(acc[ai][bj][m][1])); }     \
        __builtin_amdgcn_s_setprio(0); } while (0)
#define PG8_WAIT_V(n) asm volatile("s_waitcnt vmcnt(" #n ")" ::: "memory")
#define PG8_WAIT_L(n) asm volatile("s_waitcnt lgkmcnt(" #n ")" ::: "memory")
#define PG8_BAR __builtin_amdgcn_s_barrier()
#define PG8_SCHED __builtin_amdgcn_sched_barrier(0)
    Unit cur, nxt; int ui = 0;
    if (!S.next(0, cur)) return;
    f32x4 acc[2][2][4][2];
#pragma unroll
    for (int a = 0; a < 2; ++a)
#pragma unroll
        for (int b = 0; b < 2; ++b)
#pragma unroll
            for (int m = 0; m < 4; ++m)
#pragma unroll
                for (int n = 0; n < 2; ++n) acc[a][b][m][n] = E.init(cur, b, n, wc, fq);
    bf16x8 At[4][2], B0[2][2], B1[2][2];
    const char* cA = (const char*)g.A + (GATHER ? (size_t)0 : (size_t)(g.dry == 7 ? 0 : cur.pm) * tstep);
    PG8_GOFF(vC, 0); const char* cB = (const char*)g.Bt + (size_t)cur.e * g.estride + (size_t)cur.pn * tstep;
    S.a_ready(cur);
    if constexpr (SP2) {
        PG8_STAGE(PG8_SB(0, 0), cB, voffB); PG8_STAGE(PG8_SB(0, 1), cB + hstep, voffB); PG8_STAGE(PG8_SA(0, 0), cA, vC[0]); PG8_STAGE(PG8_SA(0, 1), cA, vC[1]);
        if (wr == 1) PG8_BAR;
        PG8_WAIT_V(2); PG8_BAR;
        PG8_STAGE(PG8_SB(1, 0), cB + kstep, voffB); PG8_STAGE(PG8_SA(1, 0), cA + kstep, vC[0]); PG8_STAGE(PG8_SB(1, 1), cB + hstep + kstep, voffB);
        PG8_WAIT_V(6); PG8_BAR;
    }
    for (;;) {
        const bool has_next = S.next(ui + 1, nxt);
        const char* nA = (has_next && !GATHER) ? (const char*)g.A + (size_t)(g.dry == 7 ? 0 : nxt.pm) * tstep : cA; const char* nB = has_next ? (const char*)g.Bt + (size_t)nxt.e * g.estride + (size_t)nxt.pn * tstep : cB;
        for (int t = 0; t < nt; t += 2) {
            const bool last = (t == nt - 2);
            const char* a1 = cA + (size_t)(t + 1) * kstep;
            const char* a2 = last ? nA : cA + (size_t)(t + 2) * kstep; const char* b2 = last ? nB : cB + (size_t)(t + 2) * kstep;
            const char* a3 = a2 + kstep; const char* b3 = b2 + kstep;
            if (last && has_next) { S.a_ready(nxt); PG8_GOFF(vN, ui + 1); }
            unsigned vX[2][2];
#pragma unroll
            for (int h_ = 0; h_ < 2; ++h_)
#pragma unroll
                for (int i_ = 0; i_ < 2; ++i_) vX[h_][i_] = (GATHER && last) ? vN[h_][i_] : vC[h_][i_];
            if constexpr (SP2) {
            PG8_LDB(B0, 0, 0); PG8_LDB(B1, 0, 1); PG8_SCHED; PG8_LDA(At, 0, 0); PG8_STAGE(PG8_SA(1, 1), a1, vC[1]);
            PG8_WAIT_V(8); PG8_WAIT_L(0); PG8_BAR; PG8_MMA(0, 0, At, B0); PG8_MMA(0, 1, At, B1); PG8_BAR; PG8_SCHED;
            PG8_LDA(At, 0, 1); PG8_STAGE(PG8_SB(0, 0), b2, voffB); PG8_STAGE(PG8_SB(0, 1), b2 + hstep, voffB); PG8_STAGE(PG8_SA(0, 0), a2, vX[0]);
            PG8_WAIT_V(8); PG8_WAIT_L(0); PG8_BAR; PG8_MMA(1, 0, At, B0); PG8_MMA(1, 1, At, B1); PG8_BAR; PG8_SCHED;
            PG8_LDB(B0, 1, 0); PG8_LDB(B1, 1, 1); PG8_SCHED; PG8_LDA(At, 1, 0); PG8_STAGE(PG8_SA(0, 1), a2, vX[1]);
            PG8_WAIT_V(8); PG8_WAIT_L(0); PG8_BAR; PG8_MMA(0, 0, At, B0); PG8_MMA(0, 1, At, B1); PG8_BAR; PG8_SCHED;
            PG8_LDA(At, 1, 1); PG8_STAGE(PG8_SB(1, 0), b3, voffB); PG8_STAGE(PG8_SB(1, 1), b3 + hstep, voffB); PG8_STAGE(PG8_SA(1, 0), a3, vX[0]);
            PG8_WAIT_V(8); PG8_WAIT_L(0); PG8_BAR; PG8_MMA(1, 0, At, B0); PG8_MMA(1, 1, At, B1); PG8_BAR; PG8_SCHED;
            }
        }
        if constexpr (ALIGN_EPI) { if (wr == 0) PG8_BAR; }
        if constexpr (!Epi::AFTER_DRAIN) { if (g.dry < 7) E(acc, cur, wr, wc, fr, fq); S.done(cur); }
        if (!has_next) break;
#pragma unroll
        for (int a = 0; a < 2; ++a)
#pragma unroll
            for (int b = 0; b < 2; ++b)
#pragma unroll
                for (int m = 0; m < 4; ++m)
#pragma unroll
                    for (int n = 0; n < 2; ++n) acc[a][b][m][n] = E.init(nxt, b, n, wc, fq);
        cur = nxt; cA = nA; cB = nB; ++ui;
        if constexpr (GATHER) {
#pragma unroll
            for (int h_ = 0; h_ < 2; ++h_)
#pragma unroll
                for (int i_ = 0; i_ < 2; ++i_) vC[h_][i_] = vN[h_][i_]; }
        if constexpr (ALIGN_EPI) { if (wr == 1) PG8_BAR; }
    }
    PG8_WAIT_V(0);
    if constexpr (!ALIGN_EPI) { if (wr == 0) PG8_BAR; }
    PG8_BAR;
    if constexpr (Epi::AFTER_DRAIN) { E.fused(acc, cur, wr, wc, fr, fq, lds, wid, lane); S.done(cur); }
#undef PG8_GOFF
#undef PG8_SA
#undef PG8_SB
#undef PG8_STAGE
#undef PG8_LDA
#undef PG8_LDB
#undef PG8_MMA
#undef PG8_WAIT_V
#undef PG8_WAIT_L
#undef PG8_BAR
#undef PG8_SCHED
}
}

constexpr int NB = 8, SEQ = 4096, D = 1024, T = NB * SEQ;
constexpr int DIN = 2464, DINP = 2560;
constexpr int NE = 32, TOPK = 4;
constexpr int NWAVES = 8, NTHR = 512;
constexpr float LN_EPS = 1e-5f, GN_EPS = 64e-5f, ALPHA = 1.189207115002721f;
constexpr int ROWS_PAD = T * TOPK + NE * 256;

constexpr size_t MiB = 1u << 20;
constexpr size_t WS_CTL = 0, CTL_ZERO_BYTES = 64 * 1024;
constexpr size_t WS_MOD = 1 * MiB;
constexpr size_t WS_TOKE = 1 * MiB + 256 * 1024;
constexpr size_t WS_TOKG = 1 * MiB + 768 * 1024;
constexpr size_t WS_SMAP = 12 * MiB;
constexpr size_t WS_WLT = 2 * MiB + 512 * 1024;
constexpr size_t WS_WIN = 3 * MiB;
constexpr size_t WS_WOUT = 8 * MiB;
constexpr size_t WS_ROT = 10 * MiB;
constexpr size_t WS_WGU = 16 * MiB;
constexpr size_t WS_STOK = 80 * MiB;
constexpr size_t WS_WDN = 144 * MiB;
constexpr size_t WS_H1 = 208 * MiB;
constexpr size_t WS_PROJ = 272 * MiB;
constexpr size_t WS_GF = 432 * MiB;
constexpr size_t WS_QF = 464 * MiB;
constexpr size_t WS_HT = 496 * MiB;
constexpr size_t WS_YL = 560 * MiB;
constexpr size_t WS_BV = 624 * MiB;
constexpr size_t WS_GG = 656 * MiB;
constexpr size_t WS_YRAW = 688 * MiB;
constexpr size_t WS_CAT = 752 * MiB;
constexpr size_t WS_YMIX = 816 * MiB;
constexpr size_t WS_X1 = 208 * MiB;
constexpr size_t WS_H2 = 336 * MiB;
constexpr size_t WS_XS = 400 * MiB;
constexpr size_t WS_ACT = 672 * MiB;
constexpr size_t WS_YB = 400 * MiB;
constexpr size_t WS_END = 944 * MiB;
constexpr int CW_BAR = 1024;
constexpr int CW_CNT = 12288;

constexpr int LDS_BYTES = 147456;
constexpr int MISC_OFF = 144384;

#define GAS __attribute__((address_space(1)))
#define LAS __attribute__((address_space(3)))
typedef unsigned short bf16;
typedef unsigned v4u __attribute__((ext_vector_type(4)));
typedef unsigned v2u __attribute__((ext_vector_type(2)));
typedef float f32x4 __attribute__((ext_vector_type(4)));
typedef float f32x2 __attribute__((ext_vector_type(2)));
typedef short bf16x8 __attribute__((ext_vector_type(8)));
#define LDS_WAIT() asm volatile("s_waitcnt lgkmcnt(0)" ::: "memory")
#define VM_WAIT() asm volatile("s_waitcnt vmcnt(0)" ::: "memory")
__device__ __forceinline__ unsigned f2bf(float f) { return pg8::cvt_pk_bf16(f, 0.f); }
__device__ __forceinline__ float bf2f(unsigned b) { return __builtin_bit_cast(float, b << 16); }
__device__ __forceinline__ unsigned pk2(float lo, float hi) { return pg8::cvt_pk_bf16(lo, hi); }
__device__ __forceinline__ float wave_sum(float v) {
#pragma unroll
    for (int o = 1; o < 64; o <<= 1) v += __shfl_xor(v, o);
    return v;
}
__device__ __forceinline__ float sigmoidf_(float x) { return __builtin_amdgcn_rcpf(1.0f + __expf(-x)); }
__device__ __forceinline__ float tanhf_(float x) { return 1.0f - 2.0f * __builtin_amdgcn_rcpf(1.0f + __expf(2.0f * x)); }
template <int CTRL> __device__ __forceinline__ float dpp_add(float v) { return v + __builtin_bit_cast(float, __builtin_amdgcn_update_dpp(0, __builtin_bit_cast(int, v), CTRL, 0xf, 0xf, true)); }
__device__ __forceinline__ float sum8(float v) { v = dpp_add<0xB1>(v); v = dpp_add<0x4E>(v); return dpp_add<0x141>(v); }
__device__ __forceinline__ float sum16(float v) { return dpp_add<0x140>(sum8(v)); }
__device__ __forceinline__ float rdl(float v, int l) { return __builtin_bit_cast(float, __builtin_amdgcn_readlane(__builtin_bit_cast(int, v), l)); }
__device__ __forceinline__ float wave_sum_u(float v) {
    v = sum16(v);
    v += __builtin_bit_cast(float, __builtin_amdgcn_update_dpp(0, __builtin_bit_cast(int, v), 0x142, 0xA, 0xF, false));
    v += __builtin_bit_cast(float, __builtin_amdgcn_update_dpp(0, __builtin_bit_cast(int, v), 0x143, 0xC, 0xF, false));
    return rdl(v, 63); }

#define XB_TMO      128
#define XB_XCNT(j)  (256  + 64 * (j))
#define XB_XSUB(j)  (1280 + 64 * (j))
#define XB_XGEN(j)  (2304 + 64 * (j))
#define XB_TOP      3328
#define XB_TOPGEN   3392
#define XCD_BAR_WORDS 3456
#define XB_SPIN_CAP (1u << 18)

__device__ __forceinline__ unsigned xb_ld(unsigned* p)              { return __hip_atomic_load(p, __ATOMIC_RELAXED, __HIP_MEMORY_SCOPE_AGENT); }
__device__ __forceinline__ unsigned xb_add(unsigned* p, unsigned v) { return __hip_atomic_fetch_add(p, v, __ATOMIC_RELAXED, __HIP_MEMORY_SCOPE_AGENT); }
__device__ __forceinline__ unsigned xb_xcc_id() { return (unsigned)__builtin_amdgcn_s_getreg((3 << 11) | 20) & 0xFu; }
#define XB_SPIN(cond, bar) do { unsigned _sp = 0; while (cond) { __builtin_amdgcn_s_sleep(1); \
    if ((++_sp & 255u) == 0u) { if (xb_ld(&(bar)[XB_TMO])) break; if (_sp > XB_SPIN_CAP) { atomicAdd(&(bar)[XB_TMO], 1u); break; } } } } while (0)

struct XcdBarrier {
    unsigned* bar; unsigned x;
    volatile LAS unsigned* st;
};
__device__ __forceinline__ XcdBarrier xcd_barrier_post(unsigned* bar, volatile LAS unsigned* st) {
    XcdBarrier b; b.bar = bar; b.x = xb_xcc_id(); b.st = st;
    if (threadIdx.x == 0) (void)xb_add(&bar[XB_XCNT(b.x)], 1u);
    return b;
}
__device__ __forceinline__ void xcd_barrier_complete(unsigned* bar, unsigned x, unsigned& nloc, unsigned& nx) {
    const unsigned G = gridDim.x * gridDim.y * gridDim.z;
    unsigned sum, cnt, mine, sp = 0u;
    for (;;) {
        sum = 0u; cnt = 0u; mine = 0u;
#pragma unroll
        for (unsigned j = 0; j < 16; ++j) { const unsigned c = xb_ld(&bar[XB_XCNT(j)]); sum += c; cnt += (c > 0u) ? 1u : 0u; mine = (j == x) ? c : mine; }
        if (sum == G) break;
        __builtin_amdgcn_s_sleep(1);
        if ((++sp & 255u) == 0u) { if (xb_ld(&bar[XB_TMO])) break; if (sp > XB_SPIN_CAP) { atomicAdd(&bar[XB_TMO], 1u); break; } }
    }
    nloc = mine > 0u ? mine : 1u; nx = cnt > 0u ? cnt : 1u;
}
__device__ __forceinline__ void xcd_barrier(const XcdBarrier& b) {
    asm volatile("s_waitcnt vmcnt(0)" ::: "memory");
    __syncthreads();
    if (threadIdx.x == 0) {
        unsigned* bar = b.bar;
        __builtin_amdgcn_s_waitcnt(0);
        unsigned nloc = b.st[0], nx = b.st[1];
        if (nloc == 0u) { xcd_barrier_complete(bar, b.x, nloc, nx); b.st[0] = nloc; b.st[1] = nx; }
        const unsigned old = xb_add(&bar[XB_XSUB(b.x)], 1u);
        const unsigned gen = old / nloc;
        if (old + 1u == (gen + 1u) * nloc) {
            __builtin_amdgcn_fence(__ATOMIC_RELEASE, "agent");
            asm volatile("s_waitcnt vmcnt(0)" ::: "memory");
            const unsigned og = xb_add(&bar[XB_TOP], 1u);
            const unsigned tg = og / nx;
            if (og + 1u == (tg + 1u) * nx) xb_add(&bar[XB_TOPGEN], 1u);
            else XB_SPIN(xb_ld(&bar[XB_TOPGEN]) == tg, bar);
            __builtin_amdgcn_fence(__ATOMIC_ACQUIRE, "agent");
            xb_add(&bar[XB_XGEN(b.x)], 1u);
            asm volatile("s_waitcnt vmcnt(0)" ::: "memory");
        } else {
            XB_SPIN(xb_ld(&bar[XB_XGEN(b.x)]) == gen, bar);
            __builtin_amdgcn_fence(__ATOMIC_ACQUIRE, "agent");
            asm volatile("s_waitcnt vmcnt(0)" ::: "memory");
        }
    }
    __syncthreads();
}

struct Args { const void* in[29]; float* out; unsigned char* ws; int ph_lo, ph_hi, li, pad; };
struct Frame {
    LAS unsigned char* lds;
    volatile LAS unsigned* MISC;
    unsigned* ctl;
    int tid, lane, wave, vcu, G;
};

__device__ __forceinline__ void p0_transpose_item(const float* W, int K, int N, bf16* WT, int k0, int n0, int orow0, LAS float* scr, int lane) {
#pragma unroll 8
    for (int i = 0; i < 32; ++i) { const int kk = 2 * i + (lane >> 5); scr[kk * 33 + (lane & 31)] = W[(size_t)(k0 + kk) * N + n0 + (lane & 31)]; }
    LDS_WAIT(); asm volatile("" ::: "memory");
    const int c = lane & 7;
#pragma unroll
    for (int j = 0; j < 4; ++j) { const int n = (lane >> 3) + 8 * j; const LAS float* s = scr + (8 * c) * 33 + n;
        v4u o; o.x = pk2(s[0 * 33], s[1 * 33]); o.y = pk2(s[2 * 33], s[3 * 33]); o.z = pk2(s[4 * 33], s[5 * 33]); o.w = pk2(s[6 * 33], s[7 * 33]);
        *(v4u*)(WT + (size_t)(orow0 + n) * K + k0 + 8 * c) = o; }
    LDS_WAIT(); asm volatile("" ::: "memory");
}
struct ConvRegs { f32x4 v[8]; };
__device__ __forceinline__ void conv_load8(ConvRegs& R, const float* W, int N, int k0, int n0, int lane) {
#pragma unroll
    for (int i = 0; i < 8; ++i) R.v[i] = *(const f32x4*)(W + (size_t)(k0 + i * 16 + (lane >> 2)) * N + n0 + 4 * (lane & 3));
}
__device__ __forceinline__ void conv_store8(const ConvRegs& R, int K, unsigned char* WT, int k0, int orow0, LAS float* scr, int lane, float sc) {
#pragma unroll
    for (int i = 0; i < 8; ++i)
#pragma unroll
        for (int j = 0; j < 4; ++j) scr[(4 * (lane & 3) + j) * 132 + i * 16 + (lane >> 2)] = R.v[i][j] * sc;
    LDS_WAIT(); asm volatile("" ::: "memory");
    const int n = lane >> 2, qd = lane & 3; const LAS f32x4* s4 = (const LAS f32x4*)(scr + n * 132 + qd * 32);
    v4u o[2];
#pragma unroll
    for (int h = 0; h < 2; ++h) { const f32x4 a0 = s4[4 * h], a1 = s4[4 * h + 1], a2 = s4[4 * h + 2], a3 = s4[4 * h + 3];
        o[h] = (v4u){pg8::pk4_fp8(a0[0], a0[1], a0[2], a0[3]), pg8::pk4_fp8(a1[0], a1[1], a1[2], a1[3]), pg8::pk4_fp8(a2[0], a2[1], a2[2], a2[3]), pg8::pk4_fp8(a3[0], a3[1], a3[2], a3[3])}; }
    v4u* dst = (v4u*)(WT + (size_t)(orow0 + n) * K + k0 + qd * 32); dst[0] = o[0]; dst[1] = o[1];
    LDS_WAIT(); asm volatile("" ::: "memory");
}
#define INF32(i) ((const float*)a.in[i])
__device__ __forceinline__ void p0_prologue(Frame& F, const Args& a) {
    unsigned char* ws = a.ws;
    if (blockIdx.x < 192) {
        const float* c_in = INF32(1); const float* w_ada = INF32(3); const float* b_ada = INF32(4);
        LAS float* sc = (LAS float*)F.lds;
        for (int i = F.tid; i < 8 * 1024; i += NTHR) { const float v = c_in[i]; sc[i] = v / (1.0f + expf(-v)); }
        __syncthreads();
        const int col = F.tid & 31, ks = F.tid >> 5, n = blockIdx.x * 32 + col;
        float acc[8];
#pragma unroll
        for (int b = 0; b < 8; ++b) acc[b] = 0.f;
#pragma unroll 16
        for (int k = ks * 64; k < ks * 64 + 64; ++k) { const float w = w_ada[(size_t)k * 6144 + n];
#pragma unroll
            for (int b = 0; b < 8; ++b) acc[b] += sc[b * 1024 + k] * w; }
        LAS float* red = (LAS float*)(F.lds + 32768);
#pragma unroll
        for (int b = 0; b < 8; ++b) red[(ks * 8 + b) * 32 + col] = acc[b];
        __syncthreads();
        if (F.tid < 256) { const int b = F.tid >> 5, cc = F.tid & 31, nn = blockIdx.x * 32 + cc; float s = b_ada[nn];
            for (int k2 = 0; k2 < 16; ++k2) s += red[(k2 * 8 + b) * 32 + cc];
            const int which = nn >> 10; if (which == 1 || which == 2 || which == 4 || which == 5) s += 1.0f;
            ((float*)(ws + WS_MOD))[b * 6144 + nn] = s; }
        __syncthreads();
    }
    LAS float* scr = (LAS float*)(F.lds + F.wave * 16384);
    const int gw = F.vcu * NWAVES + F.wave, NGW = F.G * NWAVES;
    constexpr int I_IN = 16 * 77, I_OUT = 16 * 32, NITEMS = I_IN + I_OUT;
    for (int it = gw; it < NITEMS; it += NGW) {
        int r = it;
        if (r < I_IN) { const int kb = r / 77, nb = r % 77;
            p0_transpose_item(INF32(5), 1024, DIN, (bf16*)(ws + WS_WIN), 64 * kb, 32 * nb, 32 * nb, scr, F.lane); continue; }
        r -= I_IN;
        { const int kb = r >> 5, nb = r & 31;
            p0_transpose_item(INF32(18), 1024, 1024, (bf16*)(ws + WS_WOUT), 64 * kb, 32 * nb, 32 * nb, scr, F.lane); }
    }
    for (int i = blockIdx.x * NTHR + F.tid; i < 512 * 160; i += F.G * NTHR) { const int hc2 = i / 160, kk = i - hc2 * 160;
        const float v = kk < 32 ? INF32(8)[kk * 512 + hc2] : (kk < 64 ? INF32(10)[(kk - 32) * 512 + hc2] : INF32(11)[(kk - 64) * 512 + hc2]);
        ((bf16*)(ws + WS_WLT))[i] = (bf16)f2bf(v); }
    {   const float INVF[8] = {1.0f, 0.1939227432012558f, 0.03760603070259094f, 0.007292664609849453f, 0.0014142135623842478f, 0.00027424818836152554f, 5.3182957344688475e-05f, 1.0313385246263351e-05f};
        const int* pos = (const int*)a.in[2]; float* ROT = (float*)(ws + WS_ROT);
        for (int i = blockIdx.x * NTHR + F.tid; i < T * 8; i += F.G * NTHR) { const int tok = i >> 3, fi = i & 7; float sn, cs; sincosf((float)pos[tok] * INVF[fi], &sn, &cs); ROT[tok * 16 + fi] = cs; ROT[tok * 16 + 8 + fi] = sn; } }
    { v4u* z = (v4u*)((bf16*)(ws + WS_WIN) + (size_t)DIN * 1024); const int nz = (DINP - DIN) * 1024 * 2 / 16;
      for (int i = blockIdx.x * NTHR + F.tid; i < nz; i += F.G * NTHR) z[i] = (v4u){0u, 0u, 0u, 0u}; }
}

constexpr int R2_CONV_ITEMS = 8 * 2048;
struct ConvDesc { const float* W; unsigned char* WT; int N, k0, n0, orow0; };
__device__ __forceinline__ ConvDesc moe_conv_desc(const Args& a, int h) {
    constexpr int I_GU = 32 * 8 * 64; ConvDesc d; const int it = h >> 1, hf = h & 1; int r = it;
    if (r < I_GU) { const int e = r >> 9, q = r & 511, kb = q >> 6, nb = q & 63, n0 = 32 * nb;
        const int orow0 = n0 < 1024 ? 256 * (n0 >> 7) + (n0 & 127) : 256 * ((n0 - 1024) >> 7) + 128 + ((n0 - 1024) & 127);
        d.W = INF32(23) + (size_t)e * 1024 * 2048; d.WT = a.ws + WS_WGU + (size_t)e * 2048 * 1024; d.N = 2048; d.k0 = 128 * kb; d.n0 = n0 + 16 * hf; d.orow0 = orow0 + 16 * hf; return d; }
    r -= I_GU;
    { const int e = r >> 8, q = r & 255, kb = q >> 5, nb = q & 31;
        d.W = INF32(25) + (size_t)e * 1024 * 1024; d.WT = a.ws + WS_WDN + (size_t)e * 1024 * 1024; d.N = 1024; d.k0 = 128 * kb; d.n0 = 32 * nb + 16 * hf; d.orow0 = 32 * nb + 16 * hf; return d; }
}
__device__ __forceinline__ void moe_weight_items(Frame& F, const Args& a, int gwi, int ngw, LAS float* scr) {
    constexpr int NH = 2 * (32 * 8 * 64 + 32 * 8 * 32);
    int it = gwi; if (it * 2 >= NH) return;
    ConvRegs RA, RB; ConvDesc dA = moe_conv_desc(a, 2 * it), dB = moe_conv_desc(a, 2 * it + 1);
    conv_load8(RA, dA.W, dA.N, dA.k0, dA.n0, F.lane); conv_load8(RB, dB.W, dB.N, dB.k0, dB.n0, F.lane);
#pragma unroll 1
    for (;;) { const int itn = it + ngw; const bool more = itn * 2 < NH;
        conv_store8(RA, 1024, dA.WT, dA.k0, dA.orow0, scr, F.lane, 32.0f);
        if (more) { dA = moe_conv_desc(a, 2 * itn); conv_load8(RA, dA.W, dA.N, dA.k0, dA.n0, F.lane); }
        conv_store8(RB, 1024, dB.WT, dB.k0, dB.orow0, scr, F.lane, 32.0f);
        if (!more) break;
        dB = moe_conv_desc(a, 2 * itn + 1); conv_load8(RB, dB.W, dB.N, dB.k0, dB.n0, F.lane);
        it = itn; }
}

__device__ __forceinline__ void p1_h1(Frame& F, const Args& a) {
    const float* x = INF32(0); const float* MOD = (const float*)(a.ws + WS_MOD); bf16* H1 = (bf16*)(a.ws + WS_H1);
    const int gw = F.vcu * NWAVES + F.wave, NGW = F.G * NWAVES;
    for (int m = gw; m < T; m += NGW) {
        const int b = m >> 12;
        const f32x4* xr = (const f32x4*)(x + (size_t)m * D) + F.lane;
        f32x4 v[4]; float s = 0.f;
#pragma unroll
        for (int j = 0; j < 4; ++j) { v[j] = xr[64 * j]; s += (v[j].x + v[j].y) + (v[j].z + v[j].w); }
        const float mean = wave_sum_u(s) * (1.f / D); float s2 = 0.f;
#pragma unroll
        for (int j = 0; j < 4; ++j) { v[j] = v[j] - mean; s2 += (v[j].x * v[j].x + v[j].y * v[j].y) + (v[j].z * v[j].z + v[j].w * v[j].w); }
        const float rstd = 1.f / sqrtf(wave_sum_u(s2) * (1.f / D) + LN_EPS);
        const f32x4* sh = (const f32x4*)(MOD + b * 6144) + F.lane; const f32x4* scl = (const f32x4*)(MOD + b * 6144 + 1024) + F.lane;
        v2u* o8 = (v2u*)(H1 + (size_t)m * D) + F.lane;
#pragma unroll
        for (int j = 0; j < 4; ++j) { const f32x4 o = v[j] * rstd * scl[64 * j] + sh[64 * j]; v2u w; w.x = pk2(o.x, o.y); w.y = pk2(o.z, o.w); o8[64 * j] = w; }
    }
}

__device__ __forceinline__ float bfel(const v4u& v, int e) { const unsigned w = v[e >> 1]; return (e & 1) ? __builtin_bit_cast(float, w & 0xffff0000u) : __builtin_bit_cast(float, w << 16); }
__device__ __forceinline__ void attn_unit(Frame& F, const Args& a, int unit) {
    const int kvh = unit & 1, qb = (unit >> 1) & 31, b = unit >> 6;
    const bf16* PROJ = (const bf16*)(a.ws + WS_PROJ); const float* ROT = (const float*)(a.ws + WS_ROT); bf16* CAT = (bf16*)(a.ws + WS_CAT);
    LAS unsigned char* Ks = F.lds;
    LAS unsigned char* VT = F.lds + 36864;
    const int tokq0 = b * SEQ + qb * 128, tokk0 = tokq0 - 128;
    const int fr = F.lane & 15, fq = F.lane >> 4;
    {
        const int row = F.tid >> 1, half = F.tid & 1, tk = tokk0 + row;
        const bool valid = (qb > 0) || (row >= 128);
        v4u kv[4], vv[4];
#pragma unroll
        for (int i = 0; i < 4; ++i) { kv[i] = (v4u){0u, 0u, 0u, 0u}; vv[i] = (v4u){0u, 0u, 0u, 0u}; }
        if (valid) { const v4u* kp = (const v4u*)(PROJ + (size_t)tk * DINP + 512 + kvh * 64 + half * 32); const v4u* vp = (const v4u*)(PROJ + (size_t)tk * DINP + 640 + kvh * 64 + half * 32);
#pragma unroll
            for (int i = 0; i < 4; ++i) { kv[i] = kp[i]; vv[i] = vp[i]; } }
        if (valid && half == 0) { const f32x4* rt = (const f32x4*)(ROT + (size_t)tk * 16); const f32x4 c0 = rt[0], c1 = rt[1], s0 = rt[2], s1 = rt[3]; float n1[8], n2[8];
#pragma unroll
            for (int i = 0; i < 8; ++i) { const float cs = i < 4 ? c0[i] : c1[i - 4], sn = i < 4 ? s0[i] : s1[i - 4]; const float t1 = bfel(kv[0], i), t2 = bfel(kv[1], i); n1[i] = t1 * cs - t2 * sn; n2[i] = t2 * cs + t1 * sn; }
            kv[0] = (v4u){pk2(n1[0], n1[1]), pk2(n1[2], n1[3]), pk2(n1[4], n1[5]), pk2(n1[6], n1[7])};
            kv[1] = (v4u){pk2(n2[0], n2[1]), pk2(n2[2], n2[3]), pk2(n2[4], n2[5]), pk2(n2[6], n2[7])}; }
        LAS v4u* kd = (LAS v4u*)(Ks + row * 144 + half * 64);
#pragma unroll
        for (int i = 0; i < 4; ++i) kd[i] = kv[i];
#pragma unroll
        for (int i = 0; i < 4; ++i)
#pragma unroll
            for (int e = 0; e < 8; ++e) { const unsigned w = vv[i][e >> 1]; *(LAS unsigned short*)(VT + (half * 32 + i * 8 + e) * 592 + row * 2) = (unsigned short)((e & 1) ? (w >> 16) : (w & 0xffffu)); }
        const int d = F.tid >> 3, part = F.tid & 7;
        *(LAS v2u*)(VT + d * 592 + 512 + part * 8) = (v2u){0u, 0u};
    }
    __syncthreads();
    const int g = F.wave & 3, qh = F.wave >> 2, hq = kvh * 4 + g;
    constexpr float LOG2E = 1.44269504089f;
    const float sink2 = INF32(17)[hq] * LOG2E;
    for (int mt = 0; mt < 4; ++mt) {
        const int i0 = qh * 64 + mt * 16, nlo = i0 >> 4, tq = tokq0 + i0 + fr;
        bf16x8 qf[2];
        {   const v4u* qp = (const v4u*)(PROJ + (size_t)tq * DINP + hq * 64 + 8 * fq); v4u q0 = qp[0], q1 = qp[4];
            const f32x4* rt = (const f32x4*)(ROT + (size_t)tq * 16); const f32x4 c0 = rt[0], c1 = rt[1], s0 = rt[2], s1 = rt[3];
            v4u pt; pt.x = __shfl_xor(q0.x, 16); pt.y = __shfl_xor(q0.y, 16); pt.z = __shfl_xor(q0.z, 16); pt.w = __shfl_xor(q0.w, 16);
            float nn[8];
#pragma unroll
            for (int i = 0; i < 8; ++i) { const float cs = i < 4 ? c0[i] : c1[i - 4], sn = i < 4 ? s0[i] : s1[i - 4]; const float own = bfel(q0, i), oth = bfel(pt, i);
                nn[i] = 0.125f * ((fq == 0) ? (own * cs - oth * sn) : ((fq == 1) ? (own * cs + oth * sn) : own)); }
            q0 = (v4u){pk2(nn[0], nn[1]), pk2(nn[2], nn[3]), pk2(nn[4], nn[5]), pk2(nn[6], nn[7])};
#pragma unroll
            for (int i = 0; i < 8; ++i) nn[i] = 0.125f * bfel(q1, i);
            q1 = (v4u){pk2(nn[0], nn[1]), pk2(nn[2], nn[3]), pk2(nn[4], nn[5]), pk2(nn[6], nn[7])};
            qf[0] = __builtin_bit_cast(bf16x8, q0); qf[1] = __builtin_bit_cast(bf16x8, q1); }
        f32x4 st[10];
#pragma unroll
        for (int r = 0; r < 9; ++r) { f32x4 acc = (f32x4){0.f, 0.f, 0.f, 0.f};
#pragma unroll
            for (int s = 0; s < 2; ++s) { const bf16x8 ka = *(const LAS bf16x8*)(Ks + (16 * (nlo + r) + fr) * 144 + (32 * s + 8 * fq) * 2); acc = __builtin_amdgcn_mfma_f32_16x16x32_bf16(ka, qf[s], acc, 0, 0, 0); }
            st[r] = acc; }
        st[9] = (f32x4){0.f, 0.f, 0.f, 0.f};
#pragma unroll
        for (int rg = 0; rg < 4; ++rg) { if (!(4 * fq + rg > fr)) st[0][rg] = -1e30f; if (!(4 * fq + rg <= fr)) st[8][rg] = -1e30f; }
        if (qb == 0) {
#pragma unroll
            for (int r = 0; r < 9; ++r) if (16 * (nlo + r) < 128) st[r] = (f32x4){-1e30f, -1e30f, -1e30f, -1e30f}; }
        float mx = -1e30f;
#pragma unroll
        for (int r = 0; r < 9; ++r) mx = fmaxf(mx, fmaxf(fmaxf(st[r][0], st[r][1]), fmaxf(st[r][2], st[r][3])));
        mx = fmaxf(mx, __shfl_xor(mx, 16)); mx = fmaxf(mx, __shfl_xor(mx, 32));
        const float m2 = fmaxf(mx * LOG2E, sink2);
        float l = 0.f;
#pragma unroll
        for (int r = 0; r < 9; ++r)
#pragma unroll
            for (int rg = 0; rg < 4; ++rg) { const float p = __builtin_amdgcn_exp2f(st[r][rg] * LOG2E - m2); st[r][rg] = p; l += p; }
        l += __shfl_xor(l, 16); l += __shfl_xor(l, 32); l += __builtin_amdgcn_exp2f(sink2 - m2);
        const float inv = 1.0f / l;
        bf16x8 pf[5];
#pragma unroll
        for (int ks = 0; ks < 5; ++ks) { const f32x4 p0 = st[2 * ks] * inv, p1 = st[2 * ks + 1] * inv;
            const v4u w = (v4u){pk2(p0[0], p0[1]), pk2(p0[2], p0[3]), pk2(p1[0], p1[1]), pk2(p1[2], p1[3])}; pf[ks] = __builtin_bit_cast(bf16x8, w); }
#pragma unroll
        for (int md = 0; md < 4; ++md) { f32x4 acc = (f32x4){0.f, 0.f, 0.f, 0.f};
#pragma unroll
            for (int ks = 0; ks < 5; ++ks) { const int kb = 16 * (nlo + 2 * ks) + 4 * fq; const LAS unsigned char* vp = VT + (16 * md + fr) * 592 + kb * 2;
                const v2u lo = *(const LAS v2u*)vp, hi = *(const LAS v2u*)(vp + 32); const v4u av = (v4u){lo.x, lo.y, hi.x, hi.y};
                acc = __builtin_amdgcn_mfma_f32_16x16x32_bf16(__builtin_bit_cast(bf16x8, av), pf[ks], acc, 0, 0, 0); }
            v2u w; w.x = pk2(acc[0], acc[1]); w.y = pk2(acc[2], acc[3]);
            *(v2u*)(CAT + (size_t)tq * 1024 + hq * 64 + 16 * md + 4 * fq) = w; }
    }
    __syncthreads();
}
constexpr int RS = 144, MSZ = 9216;
constexpr int L_AT = 0, L_BT = MSZ, L_KT = 2 * MSZ, L_RT = 3 * MSZ, L_BHT = 4 * MSZ, L_KHT = 5 * MSZ, L_VT = 6 * MSZ;
constexpr int L_MBRT = 7 * MSZ, L_MKRT = 8 * MSZ, L_WA = 9 * MSZ, L_XT = 10 * MSZ, L_UV = 11 * MSZ, L_LABTB = 12 * MSZ, L_LAKT = 13 * MSZ, L_LDIAG = 14 * MSZ, L_TJT = L_LDIAG + 4 * 16 * 17 * 4, L_R2END = L_TJT + 2048;
constexpr int L_LIN = 0, L_LW = 21504, L_LWP = 43008, L_LAP = 59648, LRS = 336;
static_assert(L_R2END <= MISC_OFF && L_LAP + 16640 <= MISC_OFF, "R2 LDS map");

__device__ __forceinline__ f32x4 mm64(const LAS unsigned char* A, const LAS unsigned char* B, int mt, int nt, int fr, int fq, f32x4 acc) {
#pragma unroll
    for (int s = 0; s < 2; ++s) { const bf16x8 av = *(const LAS bf16x8*)(A + (16 * mt + fr) * RS + (32 * s + 8 * fq) * 2); const bf16x8 bv = *(const LAS bf16x8*)(B + (16 * nt + fr) * RS + (32 * s + 8 * fq) * 2);
        acc = __builtin_amdgcn_mfma_f32_16x16x32_bf16(av, bv, acc, 0, 0, 0); }
    return acc;
}
__device__ __forceinline__ float softplusf_(float x) { return fmaxf(x, 0.f) + __logf(1.0f + __expf(-fabsf(x))); }

struct R2Raw { v4u cur[3], prv[3]; unsigned short r[9], k[9], v[9]; };
__device__ __forceinline__ void r2_load(R2Raw& R, const Frame& F, const Args& a, int ch) {
    const int c = ch & 63, bh = ch >> 6, h = bh & 7, b = bh >> 3, tok0 = b * SEQ + c * 64;
    const bf16* PROJ = (const bf16*)(a.ws + WS_PROJ);
#pragma unroll
    for (int i = 0; i < 3; ++i) { const int item = F.tid + 512 * i; const int t = item / 20, q = item - t * 20;
        if (item < 1280) { R.cur[i] = *(const v4u*)(PROJ + (size_t)(tok0 + t) * DINP + 2304 + 8 * q);
            R.prv[i] = (c == 0 && t == 0) ? (v4u){0u, 0u, 0u, 0u} : *(const v4u*)(PROJ + (size_t)(tok0 + t - 1) * DINP + 2304 + 8 * q); } }
    const int tg = F.wave, hc = h * 64 + F.lane; const bool hasprev = !(c == 0 && tg == 0);
#pragma unroll
    for (int u = 0; u < 9; ++u) { const size_t row = (size_t)(tok0 + 8 * tg + u - 1) * DINP; const bool ok = (u > 0) || hasprev;
        R.r[u] = ok ? PROJ[row + 768 + hc] : (unsigned short)0; R.k[u] = ok ? PROJ[row + 1280 + hc] : (unsigned short)0; R.v[u] = ok ? PROJ[row + 1792 + hc] : (unsigned short)0; }
}
__device__ __forceinline__ void r2_unit(Frame& F, const Args& a, int ch, R2Raw& R, int ch_next, int conv_h) {
    const int c = ch & 63, bh = ch >> 6, h = bh & 7, b = bh >> 3, tok0 = b * SEQ + c * 64;
    const bf16* PROJ = (const bf16*)(a.ws + WS_PROJ);
    const float* mu = INF32(6);
    LAS unsigned char* L = F.lds;
    LAS float* pc = (LAS float*)(F.lds + MISC_OFF + 256);
    LAS float* tot = (LAS float*)(F.lds + MISC_OFF + 512);
    const int fr = F.lane & 15, fq = F.lane >> 4;
    const f32x4 Z4 = (f32x4){0.f, 0.f, 0.f, 0.f};
    {   v4u wv[3];
#pragma unroll
        for (int i = 0; i < 3; ++i) { const int item = F.tid + 512 * i; if (item < 1280) wv[i] = *(const v4u*)((const bf16*)(a.ws + WS_WLT) + (size_t)h * 64 * 160 + (size_t)item * 8); }
#pragma unroll
        for (int i = 0; i < 3; ++i) { const int item = F.tid + 512 * i; const int t = item / 20, q = item - t * 20;
            if (item < 1280) { const f32x4 m0 = *(const f32x4*)(mu + 1536 + 8 * q), m1 = *(const f32x4*)(mu + 1536 + 8 * q + 4); float o[8];
                const float km = q < 4 ? 2.0f : 1.0f, ka = q < 4 ? 2.0f : 1.0f, kb = q < 4 ? -1.0f : 0.0f; const bool lin = (q >= 4 && q < 8);
#pragma unroll
                for (int e = 0; e < 8; ++e) { const float cv = bfel(R.cur[i], e), pv = bfel(R.prv[i], e); const float v = cv + (pv - cv) * (e < 4 ? m0[e] : m1[e - 4]);
                    const float sg = sigmoidf_(km * v); o[e] = lin ? v : ka * sg + kb; }
                *(LAS v4u*)(L + L_LIN + t * LRS + q * 16) = (v4u){pk2(o[0], o[1]), pk2(o[2], o[3]), pk2(o[4], o[5]), pk2(o[6], o[7])};
                *(LAS v4u*)(L + L_LW + t * LRS + q * 16) = wv[i]; } } }
    const int tg = F.wave, cc = F.lane, hc = h * 64 + cc;
    float rr[8], kx[8], vv[8];
    {   const float mr = mu[hc], mk = mu[512 + hc], mv = mu[1024 + hc];
#pragma unroll
        for (int u = 0; u < 8; ++u) { const float pr = bf2f(R.r[u]), cr = bf2f(R.r[u + 1]), pk_ = bf2f(R.k[u]), ck = bf2f(R.k[u + 1]), pv = bf2f(R.v[u]), cv = bf2f(R.v[u + 1]);
            rr[u] = cr + (pr - cr) * mr; kx[u] = ck + (pk_ - ck) * mk; vv[u] = cv + (pv - cv) * mv; } }
    __syncthreads();
    {   const int mt = F.wave >> 1; bf16x8 af[5];
#pragma unroll
        for (int s = 0; s < 5; ++s) af[s] = *(const LAS bf16x8*)(L + L_LIN + (16 * mt + fr) * LRS + (32 * s + 8 * fq) * 2);
        bf16* GG = (bf16*)(a.ws + WS_GG);
#pragma unroll
        for (int ni = 0; ni < 2; ++ni) { const int nt = 2 * (F.wave & 1) + ni; bf16x8 bfr[5];
#pragma unroll
            for (int s = 0; s < 5; ++s) bfr[s] = *(const LAS bf16x8*)(L + L_LW + (16 * nt + fr) * LRS + (32 * s + 8 * fq) * 2);
            const f32x4 dw = __builtin_amdgcn_mfma_f32_16x16x32_bf16(af[0], bfr[0], Z4, 0, 0, 0), da = __builtin_amdgcn_mfma_f32_16x16x32_bf16(af[1], bfr[1], Z4, 0, 0, 0);
            f32x4 dg = __builtin_amdgcn_mfma_f32_16x16x32_bf16(af[2], bfr[2], Z4, 0, 0, 0); dg = __builtin_amdgcn_mfma_f32_16x16x32_bf16(af[3], bfr[3], dg, 0, 0, 0); dg = __builtin_amdgcn_mfma_f32_16x16x32_bf16(af[4], bfr[4], dg, 0, 0, 0);
#pragma unroll
            for (int rg = 0; rg < 4; ++rg) { const int t = 16 * mt + 4 * fq + rg, cch = 16 * nt + fr;
                *(LAS float*)(L + L_LWP + (t * 65 + cch) * 4) = dw[rg]; *(LAS float*)(L + L_LAP + (t * 65 + cch) * 4) = da[rg];
                if (a.pad < 11) GG[(size_t)(tok0 + t) * 512 + h * 64 + cch] = (bf16)f2bf(dg[rg]); } } }
    __syncthreads();
    float ld[8], av[8], bv[8];
    {   const float kkw = INF32(12)[hc], kaw = INF32(13)[hc], rkw = INF32(14)[hc], w0 = INF32(7)[hc], a0 = INF32(9)[hc];
        bf16* BV = (bf16*)(a.ws + WS_BV);
        float al[8], sm[16];
#pragma unroll
        for (int u = 0; u < 8; ++u) { const int t = 8 * tg + u;
            const float wpv = *(const LAS float*)(L + L_LWP + (t * 65 + cc) * 4) + w0, apv = *(const LAS float*)(L + L_LAP + (t * 65 + cc) * 4) + a0;
            ld[u] = -0.6065306597126334f * sigmoidf_(wpv);
            al[u] = sigmoidf_(apv); }
#pragma unroll
        for (int u = 0; u < 8; ++u) { const float kk = kx[u] * kkw; av[u] = kk; sm[u] = kk * kk; kx[u] = kx[u] * (1.0f + (al[u] - 1.0f) * kaw); sm[8 + u] = rr[u] * kx[u] * rkw; }
#pragma unroll
        for (int i = 0; i < 16; ++i) sm[i] = dpp_add<0xB1>(sm[i]);
#pragma unroll
        for (int i = 0; i < 16; ++i) sm[i] = dpp_add<0x4E>(sm[i]);
#pragma unroll
        for (int i = 0; i < 16; ++i) sm[i] = dpp_add<0x141>(sm[i]);
#pragma unroll
        for (int i = 0; i < 16; ++i) sm[i] = dpp_add<0x140>(sm[i]);
#pragma unroll
        for (int i = 0; i < 16; ++i) sm[i] += __builtin_bit_cast(float, __builtin_amdgcn_update_dpp(0, __builtin_bit_cast(int, sm[i]), 0x142, 0xA, 0xF, false));
#pragma unroll
        for (int i = 0; i < 16; ++i) sm[i] += __builtin_bit_cast(float, __builtin_amdgcn_update_dpp(0, __builtin_bit_cast(int, sm[i]), 0x143, 0xC, 0xF, false));
#pragma unroll
        for (int i = 0; i < 16; ++i) sm[i] = rdl(sm[i], 63);
#pragma unroll
        for (int u = 0; u < 8; ++u) { const float kk = av[u] * __builtin_amdgcn_rcpf(fmaxf(sqrtf(sm[u]), 1e-12f)); av[u] = -kk; bv[u] = kk * al[u];
            if (a.pad < 11) BV[(size_t)(tok0 + 8 * tg + u) * 512 + hc] = (bf16)f2bf(sm[8 + u] * vv[u]); } }
    float cs[8]; { float run = 0.f;
#pragma unroll
        for (int u = 0; u < 8; ++u) { run += ld[u]; cs[u] = run; }
        tot[tg * 64 + cc] = run; }
    __syncthreads();
    float off = 0.f, csl = 0.f;
#pragma unroll
    for (int g2i = 0; g2i < 8; ++g2i) { const float tv = tot[g2i * 64 + cc]; off += (g2i < tg) ? tv : 0.f; csl += tv; }
    const float ecsl = __expf(csl);
    if (tg == 0) pc[cc] = ecsl;
    {   unsigned pb[4], pkk[4], pvv[4];
#pragma unroll
        for (int u2 = 0; u2 < 4; ++u2) { float xa[2], xb[2], xk[2], xr[2], hb[2], hk[2];
#pragma unroll
            for (int p = 0; p < 2; ++p) { const int u = 2 * u2 + p; const float ci = cs[u] + off, cx = ci - ld[u];
                const float eneg = __expf(-ci), epos = __builtin_amdgcn_rcpf(eneg), eh = ecsl * eneg;
                xa[p] = av[u] * __expf(cx); xb[p] = bv[u] * eneg; xk[p] = kx[u] * eneg; xr[p] = rr[u] * epos; hb[p] = bv[u] * eh; hk[p] = kx[u] * eh; }
            const int t = 8 * tg + 2 * u2; const unsigned wa = pk2(xa[0], xa[1]), wb = pk2(xb[0], xb[1]), wk = pk2(xk[0], xk[1]), wr_ = pk2(xr[0], xr[1]);
            *(LAS unsigned short*)(L + L_AT + t * RS + cc * 2) = (unsigned short)wa; *(LAS unsigned short*)(L + L_AT + (t + 1) * RS + cc * 2) = (unsigned short)(wa >> 16);
            *(LAS unsigned short*)(L + L_BT + t * RS + cc * 2) = (unsigned short)wb; *(LAS unsigned short*)(L + L_BT + (t + 1) * RS + cc * 2) = (unsigned short)(wb >> 16);
            *(LAS unsigned short*)(L + L_KT + t * RS + cc * 2) = (unsigned short)wk; *(LAS unsigned short*)(L + L_KT + (t + 1) * RS + cc * 2) = (unsigned short)(wk >> 16);
            *(LAS unsigned short*)(L + L_RT + t * RS + cc * 2) = (unsigned short)wr_; *(LAS unsigned short*)(L + L_RT + (t + 1) * RS + cc * 2) = (unsigned short)(wr_ >> 16);
            pb[u2] = pk2(hb[0], hb[1]); pkk[u2] = pk2(hk[0], hk[1]); pvv[u2] = pk2(vv[2 * u2], vv[2 * u2 + 1]); }
        *(LAS v4u*)(L + L_BHT + cc * RS + 16 * tg) = (v4u){pb[0], pb[1], pb[2], pb[3]};
        *(LAS v4u*)(L + L_KHT + cc * RS + 16 * tg) = (v4u){pkk[0], pkk[1], pkk[2], pkk[3]};
        *(LAS v4u*)(L + L_VT + cc * RS + 16 * tg) = (v4u){pvv[0], pvv[1], pvv[2], pvv[3]}; }
    __syncthreads();
    if (a.pad == 12) return;
    const int nt_ = F.wave & 3, mp = F.wave >> 2;
#pragma unroll
    for (int mi = 0; mi < 2; ++mi) { const int mt = 2 * mp + mi; const int tcol = 16 * nt_ + fr, j0 = 16 * mt + 4 * fq;
        f32x4 d1 = mm64(L + L_BT, L + L_AT, mt, nt_, fr, fq, Z4), d2 = mm64(L + L_KT, L + L_AT, mt, nt_, fr, fq, Z4);
        f32x4 d3 = mm64(L + L_BT, L + L_RT, mt, nt_, fr, fq, Z4), d4 = mm64(L + L_KT, L + L_RT, mt, nt_, fr, fq, Z4);
#pragma unroll
        for (int rg = 0; rg < 4; ++rg) { const bool lt = (j0 + rg < tcol), le = (j0 + rg <= tcol); d1[rg] = lt ? d1[rg] : 0.f; d2[rg] = lt ? d2[rg] : 0.f; d3[rg] = le ? d3[rg] : 0.f; d4[rg] = le ? d4[rg] : 0.f; }
        *(LAS v2u*)(L + L_LABTB + tcol * RS + j0 * 2) = (v2u){pk2(d1[0], d1[1]), pk2(d1[2], d1[3])};
        *(LAS v2u*)(L + L_LAKT + tcol * RS + j0 * 2) = (v2u){pk2(d2[0], d2[1]), pk2(d2[2], d2[3])};
        *(LAS v2u*)(L + L_MBRT + tcol * RS + j0 * 2) = (v2u){pk2(d3[0], d3[1]), pk2(d3[2], d3[3])};
        *(LAS v2u*)(L + L_MKRT + tcol * RS + j0 * 2) = (v2u){pk2(d4[0], d4[1]), pk2(d4[2], d4[3])};
        if (mt == nt_) {
#pragma unroll
            for (int rg = 0; rg < 4; ++rg) *(LAS float*)(L + L_LDIAG + ((mt * 16 + fr) * 17 + 4 * fq + rg) * 4) = d1[rg]; } }
    __syncthreads();
    {   const int rho = F.tid >> 3, sub = F.tid & 7, J = rho >> 4, i = rho & 15; const LAS float* dg = (const LAS float*)(L + L_LDIAG) + J * 16 * 17;
        float t0 = 0.f, t1 = 0.f;
#pragma unroll
        for (int m = 0; m < 16; ++m) { const float p = sum8(t0 * dg[m * 17 + sub] + t1 * dg[m * 17 + sub + 8]); const float tm = p + ((m == i) ? 1.f : 0.f);
            if (m < 8) { t0 = (sub == m) ? tm : t0; } else { t1 = (sub + 8 == m) ? tm : t1; } }
        *(LAS unsigned short*)(L + L_TJT + J * 512 + sub * 32 + i * 2) = (unsigned short)f2bf(t0);
        *(LAS unsigned short*)(L + L_TJT + J * 512 + (sub + 8) * 32 + i * 2) = (unsigned short)f2bf(t1); }
    __syncthreads();
    if (ch_next >= 0) r2_load(R, F, a, ch_next);
    {   const int r = 16 * (F.wave & 3) + fr; const LAS unsigned char* RH = L + (F.wave < 4 ? L_AT : L_LAKT); v2u zb[4];
#pragma unroll
        for (int J = 0; J < 4; ++J) { f32x4 acc;
#pragma unroll
            for (int rg = 0; rg < 4; ++rg) acc[rg] = bf2f(*(const LAS unsigned short*)(RH + (16 * J + 4 * fq + rg) * RS + r * 2));
            if (J >= 1) { const v2u lo = *(const LAS v2u*)(L + L_LABTB + (16 * J + fr) * RS + (4 * fq) * 2); v2u hi = (v2u){0u, 0u}, zh = (v2u){0u, 0u};
                if (J >= 2) { hi = *(const LAS v2u*)(L + L_LABTB + (16 * J + fr) * RS + (16 + 4 * fq) * 2); zh = zb[1]; }
                acc = __builtin_amdgcn_mfma_f32_16x16x32_bf16(__builtin_bit_cast(bf16x8, (v4u){lo.x, lo.y, hi.x, hi.y}), __builtin_bit_cast(bf16x8, (v4u){zb[0].x, zb[0].y, zh.x, zh.y}), acc, 0, 0, 0); }
            if (J == 3) { const v2u lo = *(const LAS v2u*)(L + L_LABTB + (48 + fr) * RS + (32 + 4 * fq) * 2);
                acc = __builtin_amdgcn_mfma_f32_16x16x32_bf16(__builtin_bit_cast(bf16x8, (v4u){lo.x, lo.y, 0u, 0u}), __builtin_bit_cast(bf16x8, (v4u){zb[2].x, zb[2].y, 0u, 0u}), acc, 0, 0, 0); }
            const v2u tj = *(const LAS v2u*)(L + L_TJT + J * 512 + fr * 32 + (4 * fq) * 2);
            const f32x4 z = __builtin_amdgcn_mfma_f32_16x16x32_bf16(__builtin_bit_cast(bf16x8, (v4u){tj.x, tj.y, 0u, 0u}), __builtin_bit_cast(bf16x8, (v4u){pk2(acc[0], acc[1]), pk2(acc[2], acc[3]), 0u, 0u}), Z4, 0, 0, 0);
            zb[J] = (v2u){pk2(z[0], z[1]), pk2(z[2], z[3])};
            if (F.wave < 4) *(LAS v2u*)(L + L_WA + r * RS + (16 * J + 4 * fq) * 2) = zb[J];
            else {
#pragma unroll
                for (int rg = 0; rg < 4; ++rg) *(LAS unsigned short*)(L + L_XT + (16 * J + 4 * fq + rg) * RS + r * 2) = (unsigned short)f2bf(z[rg]); } } }
    __syncthreads();
    if (a.pad == 13) return;
#pragma unroll
    for (int mi = 0; mi < 2; ++mi) { const int mt = 2 * mp + mi; const f32x4 d = mm64(L + L_XT, L + L_VT, mt, nt_, fr, fq, Z4);
        *(LAS v2u*)(L + L_UV + (16 * nt_ + fr) * RS + (16 * mt + 4 * fq) * 2) = (v2u){pk2(d[0], d[1]), pk2(d[2], d[3])}; }
    __syncthreads();
    {   f32x4 g0 = mm64(L + L_WA, L + L_BHT, 2 * mp, nt_, fr, fq, Z4), g1 = mm64(L + L_WA, L + L_BHT, 2 * mp + 1, nt_, fr, fq, Z4);
        if (2 * mp == nt_) {
#pragma unroll
            for (int rg = 0; rg < 4; ++rg) if (4 * fq + rg == fr) g0[rg] += pc[16 * nt_ + fr]; }
        if (2 * mp + 1 == nt_) {
#pragma unroll
            for (int rg = 0; rg < 4; ++rg) if (4 * fq + rg == fr) g1[rg] += pc[16 * nt_ + fr]; }
        v4u* GF = (v4u*)(a.ws + WS_GF) + (size_t)ch * 512 + (nt_ * 2 + mp) * 64 + F.lane;
        if (a.pad < 11) *GF = (v4u){pk2(g0[0], g0[1]), pk2(g0[2], g0[3]), pk2(g1[0], g1[1]), pk2(g1[2], g1[3])};
        f32x4 q0 = mm64(L + L_WA, L + L_MBRT, 2 * mp, nt_, fr, fq, Z4), q1 = mm64(L + L_WA, L + L_MBRT, 2 * mp + 1, nt_, fr, fq, Z4);
#pragma unroll
        for (int rg = 0; rg < 4; ++rg) { const int tcol = 16 * nt_ + fr;
            q0[rg] += bf2f(*(const LAS unsigned short*)(L + L_RT + tcol * RS + (32 * mp + 4 * fq + rg) * 2));
            q1[rg] += bf2f(*(const LAS unsigned short*)(L + L_RT + tcol * RS + (32 * mp + 16 + 4 * fq + rg) * 2)); }
        v4u* QF = (v4u*)(a.ws + WS_QF) + (size_t)ch * 512 + (nt_ * 2 + mp) * 64 + F.lane;
        if (a.pad < 11) *QF = (v4u){pk2(q0[0], q0[1]), pk2(q0[2], q0[3]), pk2(q1[0], q1[1]), pk2(q1[2], q1[3])};
        f32x4 hh[2], yy[2];
#pragma unroll
        for (int mi = 0; mi < 2; ++mi) { const int mt = 2 * mp + mi;
            hh[mi] = mm64(L + L_BHT, L + L_UV, mt, nt_, fr, fq, Z4); hh[mi] = mm64(L + L_KHT, L + L_VT, mt, nt_, fr, fq, hh[mi]);
            yy[mi] = mm64(L + L_MBRT, L + L_UV, mt, nt_, fr, fq, Z4); yy[mi] = mm64(L + L_MKRT, L + L_VT, mt, nt_, fr, fq, yy[mi]); }
        if (a.pad < 11) ((v4u*)(a.ws + WS_HT))[(size_t)ch * 512 + (nt_ * 2 + mp) * 64 + F.lane] = (v4u){pk2(hh[0][0], hh[0][1]), pk2(hh[0][2], hh[0][3]), pk2(hh[1][0], hh[1][1]), pk2(hh[1][2], hh[1][3])};
        if (a.pad < 11) ((v4u*)(a.ws + WS_YL))[(size_t)ch * 512 + (nt_ * 2 + mp) * 64 + F.lane] = (v4u){pk2(yy[0][0], yy[0][1]), pk2(yy[0][2], yy[0][3]), pk2(yy[1][0], yy[1][1]), pk2(yy[1][2], yy[1][3])}; }
    __syncthreads();
}

constexpr int R3_RING = 61440, R3_SLOT = 20480;
static_assert(R3_RING + 3 * R3_SLOT <= MISC_OFF && 7 * 8448 <= R3_RING, "scan-phase LDS map");
__device__ __forceinline__ void r3_scan(Frame& F, const Args& a) {
    if (F.wave != 0) { if (a.pad == 3) return; moe_weight_items(F, a, F.vcu * 7 + F.wave - 1, F.G * 7, (LAS float*)(F.lds + (F.wave - 1) * 8448)); return; }
    if (F.vcu >= 256 || a.pad == 4) return;
    const int bh = F.vcu >> 2, vg = F.vcu & 3;
    const unsigned char* GFb = a.ws + WS_GF + (size_t)bh * 64 * 8192 + F.lane * 16; const unsigned char* QFb = a.ws + WS_QF + (size_t)bh * 64 * 8192 + F.lane * 16;
    const unsigned char* HTb = a.ws + WS_HT + ((size_t)bh * 64 * 8 + vg * 2) * 1024 + F.lane * 16; const unsigned char* YLb = a.ws + WS_YL + ((size_t)bh * 64 * 8 + vg * 2) * 1024 + F.lane * 16;
    v4u* YT = (v4u*)(a.ws + WS_YRAW) + ((size_t)bh * 64 * 4 + vg) * 2 * 64 + F.lane;
    LAS unsigned char* ring = F.lds + R3_RING;
#define R3_ISSUE(cc) do { const int c_ = (cc) < 63 ? (cc) : 63; LAS unsigned char* sl_ = ring + ((cc) % 3) * R3_SLOT; \
        _Pragma("unroll") for (int i = 0; i < 8; ++i) __builtin_amdgcn_global_load_lds((const unsigned*)(GFb + (size_t)c_ * 8192 + i * 1024), (LAS unsigned*)(sl_ + i * 1024), 16, 0, 0); \
        _Pragma("unroll") for (int i = 0; i < 8; ++i) __builtin_amdgcn_global_load_lds((const unsigned*)(QFb + (size_t)c_ * 8192 + i * 1024), (LAS unsigned*)(sl_ + 8192 + i * 1024), 16, 0, 0); \
        _Pragma("unroll") for (int i = 0; i < 2; ++i) __builtin_amdgcn_global_load_lds((const unsigned*)(HTb + (size_t)c_ * 8192 + i * 1024), (LAS unsigned*)(sl_ + 16384 + i * 1024), 16, 0, 0); \
        _Pragma("unroll") for (int i = 0; i < 2; ++i) __builtin_amdgcn_global_load_lds((const unsigned*)(YLb + (size_t)c_ * 8192 + i * 1024), (LAS unsigned*)(sl_ + 18432 + i * 1024), 16, 0, 0); } while (0)
    f32x4 S[4];
#pragma unroll
    for (int m = 0; m < 4; ++m) S[m] = (f32x4){0.f, 0.f, 0.f, 0.f};
    R3_ISSUE(0); R3_ISSUE(1);
    for (int c = 0; c < 64; ++c) {
        R3_ISSUE(c + 2);
        asm volatile("s_waitcnt vmcnt(40)" ::: "memory");
        const LAS unsigned char* sl = ring + (c % 3) * R3_SLOT + F.lane * 16;
        v4u gfr[8], qfr[8]; f32x4 ht[4], yl[4];
#pragma unroll
        for (int i = 0; i < 8; ++i) { gfr[i] = *(const LAS v4u*)(sl + i * 1024); qfr[i] = *(const LAS v4u*)(sl + 8192 + i * 1024); }
#pragma unroll
        for (int i = 0; i < 2; ++i) { const v4u hv = *(const LAS v4u*)(sl + 16384 + i * 1024), yv = *(const LAS v4u*)(sl + 18432 + i * 1024);
            ht[2 * i] = (f32x4){bf2f(hv.x & 0xffffu), bf2f(hv.x >> 16), bf2f(hv.y & 0xffffu), bf2f(hv.y >> 16)}; ht[2 * i + 1] = (f32x4){bf2f(hv.z & 0xffffu), bf2f(hv.z >> 16), bf2f(hv.w & 0xffffu), bf2f(hv.w >> 16)};
            yl[2 * i] = (f32x4){bf2f(yv.x & 0xffffu), bf2f(yv.x >> 16), bf2f(yv.y & 0xffffu), bf2f(yv.y >> 16)}; yl[2 * i + 1] = (f32x4){bf2f(yv.z & 0xffffu), bf2f(yv.z >> 16), bf2f(yv.w & 0xffffu), bf2f(yv.w >> 16)}; }
        bf16x8 bhi[2], blo[2];
#pragma unroll
        for (int s = 0; s < 2; ++s) { float hi[8], lo[8];
#pragma unroll
            for (int j = 0; j < 8; ++j) { const float v = S[2 * s + (j >> 2)][j & 3]; const float hv = bf2f(f2bf(v)); hi[j] = hv; lo[j] = v - hv; }
            bhi[s] = __builtin_bit_cast(bf16x8, (v4u){pk2(hi[0], hi[1]), pk2(hi[2], hi[3]), pk2(hi[4], hi[5]), pk2(hi[6], hi[7])});
            blo[s] = __builtin_bit_cast(bf16x8, (v4u){pk2(lo[0], lo[1]), pk2(lo[2], lo[3]), pk2(lo[4], lo[5]), pk2(lo[6], lo[7])}); }
        asm volatile("s_waitcnt lgkmcnt(0)" ::: "memory");
#pragma unroll
        for (int m2 = 0; m2 < 4; ++m2) { f32x4 n = ht[m2];
#pragma unroll
            for (int s = 0; s < 2; ++s) { const bf16x8 af = __builtin_bit_cast(bf16x8, gfr[m2 * 2 + s]); n = __builtin_amdgcn_mfma_f32_16x16x32_bf16(af, bhi[s], n, 0, 0, 0); n = __builtin_amdgcn_mfma_f32_16x16x32_bf16(af, blo[s], n, 0, 0, 0); }
            S[m2] = n; }
        f32x4 yv[4];
#pragma unroll
        for (int mt = 0; mt < 4; ++mt) { f32x4 y = yl[mt];
#pragma unroll
            for (int s = 0; s < 2; ++s) { const bf16x8 af = __builtin_bit_cast(bf16x8, qfr[mt * 2 + s]); y = __builtin_amdgcn_mfma_f32_16x16x32_bf16(af, bhi[s], y, 0, 0, 0); }
            yv[mt] = y; }
#pragma unroll
        for (int i = 0; i < 2; ++i) YT[(size_t)c * 512 + i * 64] = (v4u){pk2(yv[2 * i][0], yv[2 * i][1]), pk2(yv[2 * i][2], yv[2 * i][3]), pk2(yv[2 * i + 1][0], yv[2 * i + 1][1]), pk2(yv[2 * i + 1][2], yv[2 * i + 1][3])};
    }
    asm volatile("s_waitcnt vmcnt(0)" ::: "memory");
#undef R3_ISSUE
}

__device__ __forceinline__ void p4b_rwkv_out(Frame& F, const Args& a) {
    const v4u* YT = (const v4u*)(a.ws + WS_YRAW); const bf16* BV = (const bf16*)(a.ws + WS_BV); const bf16* GG = (const bf16*)(a.ws + WS_GG); bf16* CAT = (bf16*)(a.ws + WS_CAT);
    const int gw = F.vcu * NWAVES + F.wave, NGW = F.G * NWAVES, fr = F.lane & 15, fq = F.lane >> 4;
    LAS float* tile = (LAS float*)(F.lds + F.wave * (16 * 68 * 4));
    const int tl = F.lane >> 2, qd = F.lane & 3;
    for (int item = gw; item < 64 * 64 * 4; item += NGW) { const int mt = item & 3, c = (item >> 2) & 63, bh = item >> 8, h = bh & 7, b = bh >> 3;
        f32x4 y[4];
#pragma unroll
        for (int vg = 0; vg < 4; ++vg) { const v4u w = YT[(((size_t)(bh * 64 + c) * 4 + vg) * 2 + (mt >> 1)) * 64 + F.lane]; const unsigned w0 = (mt & 1) ? w.z : w.x, w1 = (mt & 1) ? w.w : w.y;
            y[vg] = (f32x4){bf2f(w0 & 0xffffu), bf2f(w0 >> 16), bf2f(w1 & 0xffffu), bf2f(w1 >> 16)}; }
        const size_t tok = (size_t)b * SEQ + c * 64 + 16 * mt + tl;
        const v4u b0 = *(const v4u*)(BV + tok * 512 + h * 64 + 16 * qd), b1 = *(const v4u*)(BV + tok * 512 + h * 64 + 16 * qd + 8);
        const v4u g0 = *(const v4u*)(GG + tok * 512 + h * 64 + 16 * qd), g1 = *(const v4u*)(GG + tok * 512 + h * 64 + 16 * qd + 8);
#pragma unroll
        for (int vg = 0; vg < 4; ++vg)
#pragma unroll
            for (int rg = 0; rg < 4; ++rg) tile[(4 * fq + rg) * 68 + 16 * vg + fr] = y[vg][rg];
        LDS_WAIT(); asm volatile("" ::: "memory");
        f32x4 v[4];
#pragma unroll
        for (int j = 0; j < 4; ++j) v[j] = *(const LAS f32x4*)(tile + tl * 68 + 16 * qd + 4 * j);
        LDS_WAIT(); asm volatile("" ::: "memory");
        float s = 0.f;
#pragma unroll
        for (int j = 0; j < 4; ++j) s += (v[j][0] + v[j][1]) + (v[j][2] + v[j][3]);
        s = dpp_add<0x4E>(dpp_add<0xB1>(s));
        const float mean = s * (1.f / 64.f); float q = 0.f;
#pragma unroll
        for (int j = 0; j < 4; ++j) { v[j] = v[j] - mean; q += (v[j][0] * v[j][0] + v[j][1] * v[j][1]) + (v[j][2] * v[j][2] + v[j][3] * v[j][3]); }
        q = dpp_add<0x4E>(dpp_add<0xB1>(q));
        const float rstd = 1.f / sqrtf(q * (1.f / 64.f) + GN_EPS);
        const float* lw = INF32(15) + h * 64 + 16 * qd; const float* lb = INF32(16) + h * 64 + 16 * qd;
        float o[16];
#pragma unroll
        for (int j = 0; j < 4; ++j) { const f32x4 w4 = *(const f32x4*)(lw + 4 * j), bb4 = *(const f32x4*)(lb + 4 * j);
#pragma unroll
            for (int e = 0; e < 4; ++e) { const int ix = 4 * j + e; const float bvx = ix < 8 ? bfel(b0, ix) : bfel(b1, ix - 8), ggx = ix < 8 ? bfel(g0, ix) : bfel(g1, ix - 8);
                o[ix] = (v[j][e] * rstd * w4[e] + bb4[e] + bvx) * ggx; } }
        v4u* dst = (v4u*)(CAT + tok * 1024 + 512 + h * 64 + 16 * qd);
        dst[0] = (v4u){pk2(o[0], o[1]), pk2(o[2], o[3]), pk2(o[4], o[5]), pk2(o[6], o[7])}; dst[1] = (v4u){pk2(o[8], o[9]), pk2(o[10], o[11]), pk2(o[12], o[13]), pk2(o[14], o[15])};
    }
}
__device__ __forceinline__ void moe_table(Frame& F) {
    if (F.tid < 64) { const int e = F.lane & 31;
        const unsigned cnt = __hip_atomic_load(F.ctl + CW_CNT + 64 * e, __ATOMIC_RELAXED, __HIP_MEMORY_SCOPE_AGENT);
        const int tl = (int)((cnt + 255u) >> 8); int inc = tl;
#pragma unroll
        for (int o = 1; o < 32; o <<= 1) { const int up = __shfl_up(inc, o, 32); if (e >= o) inc += up; }
        if (F.lane < 32) { F.MISC[16 + e] = (unsigned)(inc - tl); if (e == 31) F.MISC[48] = (unsigned)inc; } }
    __syncthreads();
}
__device__ __forceinline__ void ln_stats(const f32x4 (&v)[4], float& mean, float& rstd) {
    float s = 0.f;
#pragma unroll
    for (int j = 0; j < 4; ++j) s += (v[j].x + v[j].y) + (v[j].z + v[j].w);
    mean = wave_sum_u(s) * (1.f / D); float s2 = 0.f;
#pragma unroll
    for (int j = 0; j < 4; ++j) { const f32x4 d = v[j] - mean; s2 += (d.x * d.x + d.y * d.y) + (d.z * d.z + d.w * d.w); }
    rstd = 1.f / sqrtf(wave_sum_u(s2) * (1.f / D) + LN_EPS);
}

constexpr int P6_HI = 0, P6_LO = 33024, P6_PART = 66048, P6_ASG = 82432, P6_HIST = 84480, P6_CURS = 84608, P6_BASE = 84736, P6_PAR = 86016;
struct P6Rows { f32x4 x[2][4]; v2u y[2][4]; };
struct P6Ctx { const float* x; const bf16* YMIX; const float* MOD; bf16* X1; unsigned char* H2; float* TOKG; const float* ln_g; const float* ln_b; const float* brt; int ntile; };
__device__ __forceinline__ void p6_load(P6Rows& R, const float* x, const bf16* YMIX, int tile, int w, int lane) {
#pragma unroll
    for (int t2 = 0; t2 < 2; ++t2) { const size_t tok = (size_t)16 * tile + 2 * w + t2; const f32x4* xr = (const f32x4*)(x + tok * D) + lane; const v2u* yr = (const v2u*)(YMIX + tok * D) + lane;
#pragma unroll
        for (int j = 0; j < 4; ++j) { R.x[t2][j] = xr[64 * j]; R.y[t2][j] = yr[64 * j]; } }
}
#define TOPSTEP(CTRL) { const float ov = __builtin_bit_cast(float, __builtin_amdgcn_update_dpp(0, __builtin_bit_cast(int, bv), CTRL, 0xf, 0xf, true)); const int oe = __builtin_amdgcn_update_dpp(0, be, CTRL, 0xf, 0xf, true); if (ov > bv || (ov == bv && oe < be)) { bv = ov; be = oe; } }
__device__ __forceinline__ bool p6_tile(Frame& F, const Args& a, const P6Ctx& C, P6Rows& RR, const bf16x8 (&bh)[2][4], float brt_e, int tile, int it) {
    LAS unsigned char* L = F.lds; LAS int* ASG = (LAS int*)(L + P6_ASG); LAS int* HIST = (LAS int*)(L + P6_HIST);
    const int fr = F.lane & 15, fq = F.lane >> 4, w = F.wave;
    const LAS f32x4* par = (const LAS f32x4*)(L + P6_PAR) + F.lane;
#pragma unroll
    for (int t2 = 0; t2 < 2; ++t2) { const int tl = 2 * w + t2, tok = 16 * tile + tl;
        f32x4 v[4];
#pragma unroll
        for (int j = 0; j < 4; ++j) { const v2u yv = RR.y[t2][j]; v[j] = RR.x[t2][j] * ALPHA + par[64 * j] * (f32x4){bf2f(yv.x & 0xffffu), bf2f(yv.x >> 16), bf2f(yv.y & 0xffffu), bf2f(yv.y >> 16)}; }
        float mean, rstd; ln_stats(v, mean, rstd);
        v2u* x1r = (v2u*)(C.X1 + (size_t)tok * D) + F.lane;
#pragma unroll
        for (int j = 0; j < 4; ++j) { v[j] = (v[j] - mean) * rstd * par[256 + 64 * j] + par[512 + 64 * j]; v2u xw; xw.x = pk2(v[j].x, v[j].y); xw.y = pk2(v[j].z, v[j].w); x1r[64 * j] = xw;
            v[j] = (f32x4){bf2f(xw.x & 0xffffu), bf2f(xw.x >> 16), bf2f(xw.y & 0xffffu), bf2f(xw.y >> 16)}; }
        ln_stats(v, mean, rstd);
        unsigned* h2r = (unsigned*)(C.H2 + (size_t)tok * D) + F.lane;
#pragma unroll
        for (int j = 0; j < 4; ++j) { const f32x4 hv = (v[j] - mean) * rstd * par[1024 + 64 * j] + par[768 + 64 * j];
            v2u hi; hi.x = pk2(hv.x, hv.y); hi.y = pk2(hv.z, hv.w); h2r[64 * j] = pg8::pk4_fp8(hv.x, hv.y, hv.z, hv.w);
            const float r0 = hv.x - bf2f(hi.x & 0xffffu), r1 = hv.y - bf2f(hi.x >> 16), r2 = hv.z - bf2f(hi.y & 0xffffu), r3 = hv.w - bf2f(hi.y >> 16);
            v2u lo; lo.x = pk2(r0, r1); lo.y = pk2(r2, r3);
            *(LAS v2u*)(L + P6_HI + tl * 2064 + (4 * F.lane + 256 * j) * 2) = hi; *(LAS v2u*)(L + P6_LO + tl * 2064 + (4 * F.lane + 256 * j) * 2) = lo; }
    }
    if (it + 2 < 8) p6_load(RR, C.x, C.YMIX, (tile & ~7) + ((tile + 2) & 7), w, F.lane);
    __syncthreads();
    if (a.pad == 6) return false;
    {   f32x4 acc[2] = {(f32x4){0.f, 0.f, 0.f, 0.f}, (f32x4){0.f, 0.f, 0.f, 0.f}};
#pragma unroll
        for (int s = 0; s < 4; ++s) { const bf16x8 ah = *(const LAS bf16x8*)(L + P6_HI + fr * 2064 + (128 * w + 32 * s + 8 * fq) * 2), al = *(const LAS bf16x8*)(L + P6_LO + fr * 2064 + (128 * w + 32 * s + 8 * fq) * 2);
#pragma unroll
            for (int nt = 0; nt < 2; ++nt) { acc[nt] = __builtin_amdgcn_mfma_f32_16x16x32_bf16(ah, bh[nt][s], acc[nt], 0, 0, 0); acc[nt] = __builtin_amdgcn_mfma_f32_16x16x32_bf16(al, bh[nt][s], acc[nt], 0, 0, 0); } }
#pragma unroll
        for (int nt = 0; nt < 2; ++nt)
#pragma unroll
            for (int rg = 0; rg < 4; ++rg) *(LAS float*)(L + P6_PART + ((w * 16 + 4 * fq + rg) * 32 + 16 * nt + fr) * 4) = acc[nt][rg]; }
    __syncthreads();
    {   const int tl = F.tid >> 5, e = F.tid & 31, tok = 16 * tile + tl;
        float v = brt_e;
#pragma unroll
        for (int w2 = 0; w2 < 8; ++w2) v += *(const LAS float*)(L + P6_PART + ((w2 * 16 + tl) * 32 + e) * 4);
        float sv[4]; int se[4];
#pragma unroll
        for (int r = 0; r < 4; ++r) { float bv = v; int be = e;
            TOPSTEP(0xB1) TOPSTEP(0x4E) TOPSTEP(0x141) TOPSTEP(0x140)
            { const float ov = __shfl_xor(bv, 16); const int oe = __shfl_xor(be, 16); if (ov > bv || (ov == bv && oe < be)) { bv = ov; be = oe; } }
            sv[r] = bv; se[r] = be; if (e == be) v = -3.0e38f; }
        if (e == 0 && a.pad < 5) { const float e1 = __expf(sv[1] - sv[0]), e2 = __expf(sv[2] - sv[0]), e3 = __expf(sv[3] - sv[0]); const float inv = 1.0f / (1.0f + e1 + e2 + e3);
            *(f32x4*)(C.TOKG + (size_t)tok * 4) = (f32x4){inv, e1 * inv, e2 * inv, e3 * inv};
#pragma unroll
            for (int r = 0; r < 4; ++r) { ASG[(it * 16 + tl) * 4 + r] = se[r]; __hip_atomic_fetch_add(&HIST[se[r]], 1, __ATOMIC_RELAXED, __HIP_MEMORY_SCOPE_WORKGROUP); } } }
    return true;
}
#undef TOPSTEP
__device__ __forceinline__ void p6_route(Frame& F, const Args& a) {
    P6Ctx C; C.x = INF32(0); C.YMIX = (const bf16*)(a.ws + WS_YMIX); C.MOD = (const float*)(a.ws + WS_MOD); C.X1 = (bf16*)(a.ws + WS_X1); C.H2 = a.ws + WS_H2; C.TOKG = (float*)(a.ws + WS_TOKG);
    C.ln_g = INF32(19); C.ln_b = INF32(20); C.brt = INF32(22); C.ntile = T / 16;
    int* TOKE = (int*)(a.ws + WS_TOKE);
    LAS unsigned char* L = F.lds;
    LAS int* ASG = (LAS int*)(L + P6_ASG); LAS int* HIST = (LAS int*)(L + P6_HIST); LAS int* CURS = (LAS int*)(L + P6_CURS); LAS int* BASE = (LAS int*)(L + P6_BASE);
    const int fr = F.lane & 15, fq = F.lane >> 4, w = F.wave;
    if (F.tid < 32) { HIST[F.tid] = 0; CURS[F.tid] = 0; }
    { int* SMAP = (int*)(a.ws + WS_SMAP); for (int i = blockIdx.x * NTHR + F.tid; i < ROWS_PAD; i += F.G * NTHR) SMAP[i] = -1; }
    static_assert(T / 16 == 8 * 256, "eight consecutive 16-token tiles per workgroup");
    const int tile0 = 8 * F.vcu, bb = (16 * tile0) >> 12;
    const int rot = F.vcu & 7;
    P6Rows RA, RB; p6_load(RA, C.x, C.YMIX, tile0 + rot, w, F.lane); p6_load(RB, C.x, C.YMIX, tile0 + ((rot + 1) & 7), w, F.lane);
    for (int i = F.tid; i < 5 * 256; i += NTHR) { const int vsel = i >> 8, q4 = i & 255;
        const float* src = vsel == 0 ? C.MOD + bb * 6144 + 2048 : (vsel == 1 ? C.ln_g : (vsel == 2 ? C.ln_b : (vsel == 3 ? C.MOD + bb * 6144 + 3072 : C.MOD + bb * 6144 + 4096)));
        *((LAS f32x4*)(L + P6_PAR) + i) = *((const f32x4*)src + q4); }
    const float brt_e = C.brt[F.tid & 31];
    bf16x8 bh[2][4];
    {   const float* wr = INF32(21);
#pragma unroll
        for (int nt = 0; nt < 2; ++nt)
#pragma unroll
            for (int s = 0; s < 4; ++s) { float hi[8];
#pragma unroll
                for (int j = 0; j < 8; ++j) hi[j] = wr[(size_t)(128 * w + 32 * s + 8 * fq + j) * 32 + 16 * nt + fr];
                bh[nt][s] = __builtin_bit_cast(bf16x8, (v4u){pk2(hi[0], hi[1]), pk2(hi[2], hi[3]), pk2(hi[4], hi[5]), pk2(hi[6], hi[7])}); } }
    __syncthreads();
    int it = 0;
#pragma unroll 1
    for (; it < 8; ) {
        if (!p6_tile(F, a, C, RA, bh, brt_e, tile0 + ((it + rot) & 7), it)) return; ++it; __builtin_amdgcn_sched_barrier(0);
        if (!p6_tile(F, a, C, RB, bh, brt_e, tile0 + ((it + rot) & 7), it)) return; ++it; __builtin_amdgcn_sched_barrier(0); }
    __syncthreads();
    if (a.pad >= 5) return;
    if (F.tid < 32) BASE[F.tid] = (int)__hip_atomic_fetch_add(F.ctl + CW_CNT + 64 * F.tid, (unsigned)HIST[F.tid], __ATOMIC_RELAXED, __HIP_MEMORY_SCOPE_AGENT);
    __syncthreads();
    {   const int ai = F.tid, nasg = it * 64;
        if (ai < nasg) { const int e = ASG[ai]; const int idx = BASE[e] + __hip_atomic_fetch_add(&CURS[e], 1, __ATOMIC_RELAXED, __HIP_MEMORY_SCOPE_WORKGROUP);
            const int i2 = ai >> 6, tl = (ai >> 2) & 15, k = ai & 3, tok = 16 * (8 * F.vcu + ((i2 + rot) & 7)) + tl;
            TOKE[(size_t)tok * 4 + k] = (e << 16) | idx; ((int*)(a.ws + WS_STOK))[e * 32768 + idx] = tok; } }
    __syncthreads();
}

__device__ __forceinline__ void p6b_scatter(Frame& F, const Args& a) {
    moe_table(F);
    const unsigned char* H2 = a.ws + WS_H2; unsigned char* XS = a.ws + WS_XS; const int* TOKE = (const int*)(a.ws + WS_TOKE); int* SMAP = (int*)(a.ws + WS_SMAP);
    const int gw = F.vcu * NWAVES + F.wave, NGW = F.G * NWAVES;
    for (int tok = gw; tok < T; tok += NGW) {
        const v4u r0 = *((const v4u*)(H2 + (size_t)tok * D) + F.lane);
#pragma unroll
        for (int k = 0; k < 4; ++k) { const int ei = TOKE[(size_t)tok * 4 + k]; const int e = ei >> 16, idx = ei & 0xffff; const size_t slot = (size_t)256 * F.MISC[16 + e] + idx;
            *((v4u*)(XS + slot * D) + F.lane) = r0; if (F.lane == 0) SMAP[slot] = tok * 4 + k; }
    }
}

typedef int i32x4 __attribute__((ext_vector_type(4)));
struct P9Rows { unsigned y[4][4]; v2u x1[4]; f32x4 gk; };
struct P9Ctx { const bf16* X1; const unsigned char* YB; const float* MOD; const int* TOKE; const float* TOKG; const float* g2; const float* b2; float* out; int dry; };
__device__ __forceinline__ void p9_rows(P9Rows& R, const Frame& F, const P9Ctx& C, int tok) {
    R.gk = *(const f32x4*)(C.TOKG + (size_t)tok * 4);
    const v2u* x1r = (const v2u*)(C.X1 + (size_t)tok * D) + F.lane;
#pragma unroll
    for (int j = 0; j < 4; ++j) R.x1[j] = x1r[64 * j];
#pragma unroll
    for (int k = 0; k < 4; ++k) { const unsigned* yr = (const unsigned*)(C.YB + ((size_t)tok * 4 + k) * D) + F.lane;
#pragma unroll
        for (int j = 0; j < 4; ++j) R.y[k][j] = yr[64 * j]; }
}
__device__ __forceinline__ f32x4 fp84(const unsigned w) { const f32x2 lo = __builtin_amdgcn_cvt_pk_f32_fp8((int)w, false), hi = __builtin_amdgcn_cvt_pk_f32_fp8((int)w, true); return (f32x4){lo[0], lo[1], hi[0], hi[1]}; }
__device__ __forceinline__ f32x4 bf4(const v2u w) { return (f32x4){bf2f(w.x & 0xffffu), bf2f(w.x >> 16), bf2f(w.y & 0xffffu), bf2f(w.y >> 16)}; }
__device__ __forceinline__ void p9_token(const Frame& F, const P9Ctx& C, P9Rows& R, int tok0, int o, int rot, int& nbad) {
    const int tok = tok0 + ((o + rot) & 15);
    const LAS f32x4* par = (const LAS f32x4*)F.lds + F.lane;
    f32x4 acc[4];
#pragma unroll
    for (int j = 0; j < 4; ++j) acc[j] = (fp84(R.y[0][j]) * R.gk[0] + fp84(R.y[1][j]) * R.gk[1] + fp84(R.y[2][j]) * R.gk[2] + fp84(R.y[3][j]) * R.gk[3]) * 0.0625f;
    f32x4 v[4];
#pragma unroll
    for (int j = 0; j < 4; ++j) v[j] = bf4(R.x1[j]) * ALPHA + par[64 * j] * acc[j];
    if (o + 2 < 16) p9_rows(R, F, C, tok0 + ((o + 2 + rot) & 15));
    float mean, rstd; ln_stats(v, mean, rstd);
    f32x4* orow = (f32x4*)(C.out + (size_t)tok * D) + F.lane;
#pragma unroll
    for (int j = 0; j < 4; ++j) { f32x4 o = (v[j] - mean) * rstd * par[256 + 64 * j] + par[512 + 64 * j];
#if MK_DEBUG
#pragma unroll
        for (int q = 0; q < 4; ++q) if (!(fabsf(o[q]) < 1e30f)) { o[q] = 0.f; ++nbad; }
#endif
        if (C.dry != 9) orow[64 * j] = o; else if (o[0] == 123.456f) orow[64 * j] = o; }
}
__device__ __forceinline__ void p9_final(Frame& F, const Args& a) {
    P9Ctx C; C.X1 = (const bf16*)(a.ws + WS_X1); C.YB = a.ws + WS_YB; C.MOD = (const float*)(a.ws + WS_MOD); C.TOKE = (const int*)(a.ws + WS_TOKE); C.TOKG = (const float*)(a.ws + WS_TOKG);
    C.g2 = INF32(27); C.b2 = INF32(28); C.out = a.out; C.dry = a.pad;
    static_assert(T == 256 * NWAVES * 16, "sixteen consecutive tokens per wave");
    const int gw = F.vcu * NWAVES + F.wave, tok0 = 16 * gw, bb = tok0 >> 12; int nbad = 0; (void)nbad;
    const int rot = gw & 15;
    P9Rows RA, RB; p9_rows(RA, F, C, tok0 + rot); p9_rows(RB, F, C, tok0 + ((1 + rot) & 15));
    for (int i = F.tid; i < 3 * 256; i += NTHR) { const int vsel = i >> 8, q4 = i & 255; const float* src = vsel == 0 ? C.MOD + bb * 6144 + 5120 : (vsel == 1 ? C.g2 : C.b2); *((LAS f32x4*)F.lds + i) = *((const f32x4*)src + q4); }
    __syncthreads();
#pragma unroll 1
    for (int o = 0; o < 16; o += 2) { p9_token(F, C, RA, tok0, o, rot, nbad); __builtin_amdgcn_sched_barrier(0); p9_token(F, C, RB, tok0, o + 1, rot, nbad); __builtin_amdgcn_sched_barrier(0); }
#if MK_DEBUG
    { float nb = wave_sum((float)nbad); if (F.lane == 0 && nb > 0.f) atomicAdd(F.ctl + 16, (unsigned)nb); }
#endif
}

#ifndef MK_DEBUG
#define MK_DEBUG 0
#endif
#ifndef MK_PROBE
#define MK_PROBE 0
#endif
#ifndef MK_LASTPH
#define MK_LASTPH 12
#endif
constexpr int NPHASE = (MK_DEBUG || MK_PROBE) ? 13 : 12;
__global__ void __launch_bounds__(NTHR, 2) mk_fwd(Args a) {
    extern __shared__ __attribute__((aligned(16))) unsigned char lds[];
    Frame F;
    F.lds = (LAS unsigned char*)lds;
    F.MISC = (volatile LAS unsigned*)(F.lds + MISC_OFF);
    F.tid = threadIdx.x; F.lane = F.tid & 63; F.wave = __builtin_amdgcn_readfirstlane(F.tid >> 6);
    F.G = gridDim.x; { const int bx = blockIdx.x; F.vcu = (F.G % 8 == 0) ? (bx % 8) * (F.G / 8) + bx / 8 : bx; }
    F.ctl = (unsigned*)(a.ws + WS_CTL);
    for (int u = F.tid; u < 64; u += NTHR) F.MISC[u] = 0u;
    __syncthreads();
    XcdBarrier bar; bar.bar = F.ctl + CW_BAR + a.li * XCD_BAR_WORDS; bar.x = 0; bar.st = nullptr;
#if !MK_PER_PHASE
    bar = xcd_barrier_post(F.ctl + CW_BAR + a.li * XCD_BAR_WORDS, F.MISC + 8);
#define GRID_BAR() xcd_barrier(bar)
#else
#define GRID_BAR() do {} while (0)
#endif
    const int lo = a.ph_lo, hi = a.ph_hi;
#ifndef PHASE_MASK
#define PHASE_MASK 0xFFF
#endif
#define IN(k) (((PHASE_MASK >> (k)) & 1) && lo <= (k) && (k) < hi)
#define SEAM(k) do { if (IN(k) && IN((k) + 1)) GRID_BAR(); } while (0)
    unsigned char* ws = a.ws;
    using namespace pg8;
    if (IN(0)) { p0_prologue(F, a); } SEAM(0);
    if (IN(1)) { p1_h1(F, a); } SEAM(1);
    if (IN(2)) {
        Gemm g{(const bf16_t*)(ws + WS_H1), (const bf16_t*)(ws + WS_WIN), 1024, 0}; StaticOrder S; S.init(T, DINP, F.G, (int)blockIdx.x);
        EpiBf16 E{(bf16_t*)(ws + WS_PROJ), DINP, nullptr, 0};
        gemm_phase<EpiBf16, StaticOrder, true, true>(F.lds, g, S, E);
    } SEAM(2);
    if (IN(3)) {
        if (a.pad != 2) for (int u = F.vcu; u < 512; u += F.G) attn_unit(F, a, u);
        if (a.pad != 1) { R2Raw R; if (F.vcu < 4096) r2_load(R, F, a, F.vcu); int ui = 0; const int gwv = F.vcu * NWAVES + F.wave;
            for (int u = F.vcu; u < 4096; u += F.G, ++ui) r2_unit(F, a, u, R, u + F.G < 4096 ? u + F.G : -1, -1); (void)gwv; }
    } SEAM(3);
    if (IN(4)) { r3_scan(F, a); } SEAM(4);
    if (IN(5)) { p4b_rwkv_out(F, a); } SEAM(5);
    if (IN(6)) {
        Gemm g{(const bf16_t*)(ws + WS_CAT), (const bf16_t*)(ws + WS_WOUT), 1024, 0}; StaticOrder S; S.init(T, 1024, F.G, (int)blockIdx.x);
        EpiBf16 E{(bf16_t*)(ws + WS_YMIX), 1024, nullptr, 0};
        gemm_phase<EpiBf16, StaticOrder, true, true>(F.lds, g, S, E);
    } SEAM(6);
    if (IN(7)) { p6_route(F, a); } SEAM(7);
    if (IN(9)) {
        moe_table(F);
        {
            const int* TOKE = (const int*)(ws + WS_TOKE); int* SMAP = (int*)(ws + WS_SMAP);
            for (int i = blockIdx.x * NTHR + F.tid; i < T * 4; i += F.G * NTHR) { const int ei = TOKE[i]; SMAP[256 * (int)F.MISC[16 + (ei >> 16)] + (ei & 0xffff)] = i; } }
        MoeOrder S{(const LAS int*)(F.lds + MISC_OFF + 64), 8, F.G, F.vcu};
        LAS unsigned short* tl = (LAS unsigned short*)(F.lds + 131072);
        {   const int* STOK = (const int*)(ws + WS_STOK); pg8::Unit u;
            for (int ui = 0; ui < 17 && S.next(ui, u); ++ui) { const int r = F.tid & 255; if ((F.tid >> 8) != (ui & 1)) continue;
                const int idx = 256 * (u.pm - (int)F.MISC[16 + u.e]) + r; const int cnt = (int)__hip_atomic_load(F.ctl + CW_CNT + 64 * u.e, __ATOMIC_RELAXED, __HIP_MEMORY_SCOPE_AGENT);
                tl[ui * 256 + r] = (unsigned short)(idx < cnt ? STOK[u.e * 32768 + idx] : 0); } }
        __syncthreads();
        Gemm g{(const bf16_t*)(ws + WS_H2), (const bf16_t*)(ws + WS_WGU), 512, (size_t)2048 * 1024, 0x7F7F7F7F, 0x7A7A7A7A, a.pad, tl};
        EpiSwiglu8 E{ws + WS_ACT, INF32(24)};
        gemm_phase<EpiSwiglu8, MoeOrder, true, true, true, true>(F.lds, g, S, E);
    } SEAM(9);
    if (IN(10)) {
        moe_table(F);
        Gemm g{(const bf16_t*)(ws + WS_ACT), (const bf16_t*)(ws + WS_WDN), 512, (size_t)1024 * 1024, 0x7F7F7F7F, 0x7A7A7A7A, a.pad}; MoeOrder S{(const LAS int*)(F.lds + MISC_OFF + 64), 4, F.G, F.vcu};
        EpiScatter E{ws + WS_YB, INF32(26), (const int*)(ws + WS_SMAP)};
        gemm_phase<EpiScatter, MoeOrder, true, true, true>(F.lds, g, S, E);
    } SEAM(10);
    if (IN(11)) { p9_final(F, a); } SEAM(11);
#if MK_PROBE
    if (lo <= 12 && 12 < hi) {
        const size_t n = (size_t)T * D; const size_t i0 = (size_t)blockIdx.x * NTHR + F.tid, st = (size_t)F.G * NTHR;
        const bf16* H1 = (const bf16*)(ws + WS_H1); const bf16* PROJ = (const bf16*)(ws + WS_PROJ); const bf16* CAT = (const bf16*)(ws + WS_CAT); const bf16* BV = (const bf16*)(ws + WS_BV); const bf16* GG = (const bf16*)(ws + WS_GG);
        const float* HT = (const float*)(ws + WS_HT); const float* YL = (const float*)(ws + WS_YL); const bf16* GF = (const bf16*)(ws + WS_GF); const bf16* QF = (const bf16*)(ws + WS_QF);
        const float* YRAW = (const float*)(ws + WS_YRAW); const bf16* YMIXb = (const bf16*)(ws + WS_YMIX); const bf16* X1 = (const bf16*)(ws + WS_X1); const unsigned char* H2 = ws + WS_H2;
        const float* TOKG = (const float*)(ws + WS_TOKG); const int* TOKE = (const int*)(ws + WS_TOKE);
        for (size_t i = i0; i < n; i += st) { const size_t tok = i >> 10; const int k = (int)(i & 1023); float v = 0.f;
            if (MK_PROBE == 1) v = bf2f(H1[i]);
            if (MK_PROBE == 2) v = bf2f(PROJ[tok * DINP + k]) + bf2f(PROJ[tok * DINP + 1024 + k]) + bf2f(PROJ[tok * DINP + (k + 2048 < DIN ? k + 2048 : DIN - 1)]);
            if (MK_PROBE == 3) v = k < 512 ? bf2f(CAT[tok * 1024 + k]) : bf2f(BV[tok * 512 + k - 512]) + bf2f(GG[tok * 512 + k - 512]);
            if (MK_PROBE == 4) { const size_t h = n >> 1; v = bf2f(GF[i % h]) + bf2f(QF[i % h]); }
            if (MK_PROBE == 5) v = YRAW[i >> 2];
            if (MK_PROBE == 6) v = bf2f(CAT[i]);
            if (MK_PROBE == 7) v = bf2f(YMIXb[i]);
            if (MK_PROBE == 8) v = bf2f(X1[i]) + (float)H2[i] + TOKG[tok * 4 + (k & 3)] + (float)(TOKE[tok * 4 + (k & 3)] >> 16);
            if (MK_PROBE == 9) v = k < 512 ? bf2f(CAT[tok * 1024 + k]) : 0.f;
            if (MK_PROBE == 10) v = k < 512 ? bf2f(BV[tok * 512 + k]) : 0.f;
            if (MK_PROBE == 11) v = k < 512 ? bf2f(GG[tok * 512 + k]) : 0.f;
            if (!(fabsf(v) < 1e30f)) v = 12345.f;
            a.out[i] = v; }
    }
#elif MK_DEBUG
    if (lo <= 12 && 12 < hi) { if (blockIdx.x == 0 && F.tid == 0) { const unsigned nb = __hip_atomic_load(F.ctl + 16, __ATOMIC_RELAXED, __HIP_MEMORY_SCOPE_AGENT); if (nb) a.out[0] = 1.0e4f * sqrtf((float)nb); } }
#endif
#undef IN
#undef SEAM
}

extern "C" void kernel_launch(void* const* d_in, const int* in_sizes, int n_in, void* d_out, int out_size, void* d_ws, size_t ws_size, hipStream_t stream) {
    static int grid = 0;
    if (grid == 0) {
        if (n_in != 29 || in_sizes[0] != T * D || out_size != T * D || ws_size < WS_END) { fprintf(stderr, "kernel_launch: unexpected shapes (n_in %d, in0 %d, out %d, ws %zu < %zu); nothing launched\n", n_in, n_in > 0 ? in_sizes[0] : -1, out_size, ws_size, (size_t)WS_END); grid = -1; return; }
        int dev = 0, cus = 0, per_cu = 0;
        if (hipGetDevice(&dev) != hipSuccess || hipDeviceGetAttribute(&cus, hipDeviceAttributeMultiprocessorCount, dev) != hipSuccess) { grid = -1; return; }
        if (hipFuncSetAttribute((const void*)mk_fwd, hipFuncAttributeMaxDynamicSharedMemorySize, LDS_BYTES) != hipSuccess) { fprintf(stderr, "kernel_launch: hipFuncSetAttribute failed\n"); grid = -1; return; }
        if (hipOccupancyMaxActiveBlocksPerMultiprocessor(&per_cu, (const void*)mk_fwd, NTHR, LDS_BYTES) != hipSuccess || per_cu < 1) fprintf(stderr, "kernel_launch: occupancy query reports %d\n", per_cu);
        (void)hipGetLastError();
        grid = cus < 256 ? cus : 256;
    }
    if (grid < 0) return;
    if (hipMemsetAsync((char*)d_ws + WS_CTL, 0, CTL_ZERO_BYTES, stream) != hipSuccess) { fprintf(stderr, "kernel_launch: memset failed\n"); return; }
    Args a{};
    for (int i = 0; i < 29; ++i) a.in[i] = d_in[i];
    a.out = (float*)d_out; a.ws = (unsigned char*)d_ws;
#if MK_PER_PHASE
    for (int p = 0; p < NPHASE; ++p) { if (p >= MK_LASTPH && p != 12) continue; a.ph_lo = p; a.ph_hi = p + 1; hipLaunchKernelGGL(mk_fwd, dim3(grid), dim3(NTHR), LDS_BYTES, stream, a); }
#else
#if defined(TIME_PHASE)
    a.ph_lo = 0; a.ph_hi = TIME_PHASE + 1; a.li = 0; hipLaunchKernelGGL(mk_fwd, dim3(grid), dim3(NTHR), LDS_BYTES, stream, a);
    a.ph_lo = TIME_PHASE; a.ph_hi = TIME_PHASE + 1; a.li = 1;
#ifdef TIME_SUB
    a.pad = TIME_SUB;
#endif
    hipLaunchKernelGGL(mk_fwd, dim3(grid), dim3(NTHR), LDS_BYTES, stream, a); a.pad = 0;
    if (TIME_PHASE + 1 < NPHASE) { a.ph_lo = TIME_PHASE + 1; a.ph_hi = NPHASE; a.li = 2; hipLaunchKernelGGL(mk_fwd, dim3(grid), dim3(NTHR), LDS_BYTES, stream, a); }
#else
    a.ph_lo = 0; a.ph_hi = NPHASE; hipLaunchKernelGGL(mk_fwd, dim3(grid), dim3(NTHR), LDS_BYTES, stream, a);
#endif
#endif
}
```

```cpp
#include <hip/hip_runtime.h>
#include <cstdio>
#include <cstdint>

#ifndef MK_PER_PHASE
#define MK_PER_PHASE 0
#endif

namespace pg8 {
#define PG8_LAS __attribute__((address_space(3)))
typedef unsigned short bf16_t;
typedef short bf16x8 __attribute__((ext_vector_type(8)));
typedef float f32x4 __attribute__((ext_vector_type(4)));
typedef unsigned u32x4 __attribute__((ext_vector_type(4)));
constexpr int BM = 256, BK = 64, HALF = 128, HTB = HALF * BK * 2  , STAGE_BYTES = 8 * HTB, NXCD = 8, WGM = 8;

__host__ __device__ __forceinline__ int lds_byte(int r, int c) { const int st = (r >> 4) * 2 + (c >> 5), rr = r & 15, cc = c & 31, ob = rr * 64 + cc * 2; return st * 1024 + (ob ^ (((ob >> 9) & 1) << 5)); }
__host__ __device__ __forceinline__ void stage_rc(int b, int& R, int& C) { const int st = b / 1024, sb = b % 1024, swz = sb ^ (((sb >> 9) & 1) << 5); R = (st >> 1) * 16 + swz / 64; C = (st & 1) * 32 + (swz % 64) / 2; }
__host__ __device__ __forceinline__ int perm32(int rho) { const int n = rho >> 4, i = rho & 15; return 8 * (i >> 2) + 4 * n + (i & 3); }

struct Unit { int pm, pn, e; };
struct Gemm { const bf16_t* A; const bf16_t* Bt; int K; size_t estride; int scale_a, scale_b, dry; const PG8_LAS unsigned short* toklist; };
typedef int v8i_t __attribute__((ext_vector_type(8)));
typedef v8i_t v8i_a16 __attribute__((aligned(16)));
__device__ __forceinline__ v8i_t cat8(bf16x8 lo, bf16x8 hi) { typedef int v4i_t __attribute__((ext_vector_type(4))); const v4i_t a = __builtin_bit_cast(v4i_t, lo), b = __builtin_bit_cast(v4i_t, hi); return (v8i_t){a[0], a[1], a[2], a[3], b[0], b[1], b[2], b[3]}; }

struct StaticOrder {
    int nM, nN, nwg, G, c;
    __device__ void init(int M, int N, int G_, int c_) { nM = M / BM; nN = N / BM; nwg = nM * nN; G = G_; c = c_; }
    __device__ bool next(int i, Unit& u) const {
        const long L = (long)i * G + c; if (L >= nwg) return false;
        int wgid = (int)L; { const int q = nwg / NXCD, r = nwg % NXCD, xcd = wgid % NXCD, off = wgid / NXCD; wgid = (xcd < r ? xcd * (q + 1) : r * (q + 1) + (xcd - r) * q) + off; }
        const int nig = WGM * nN, gid = wgid / nig, fm = gid * WGM, gsz = (nM - fm) < WGM ? (nM - fm) : WGM;
        u.pm = fm + ((wgid % nig) % gsz); u.pn = (wgid % nig) / gsz; u.e = 0; return true;
    }
    __device__ __forceinline__ void a_ready(const Unit&) const {}
    __device__ __forceinline__ void done(const Unit&) const {}
};
struct MoeOrder {
    const PG8_LAS int* ts; int NT, G, c;
    __device__ bool next(int i, Unit& u) const {
        const int L = i * G + c; const int ntl = ts[32];
        if (L >= ntl * NT) return false;
        const int tau = L / NT; u.pm = tau; u.pn = L - tau * NT; int e = 0;
#pragma unroll 1
        for (int j = 1; j < 32; ++j) e += (ts[j] <= tau) ? 1 : 0;
        u.e = e; return true;
    }
    __device__ __forceinline__ void a_ready(const Unit&) const {}
    __device__ __forceinline__ void done(const Unit&) const {}
};

typedef __bf16 bf16x2_t __attribute__((ext_vector_type(2)));
__device__ __forceinline__ unsigned cvt_pk_bf16(float lo, float hi) { const bf16x2_t v = {(__bf16)lo, (__bf16)hi}; return __builtin_bit_cast(unsigned, v); }

struct EpiF32 {
    static constexpr bool PERM = false, AFTER_DRAIN = false;
    __device__ __forceinline__ f32x4 init(const Unit&, int, int, int, int) const { return (f32x4){0.f, 0.f, 0.f, 0.f}; }
    float* C; int ldc;
    __device__ __forceinline__ void operator()(const f32x4 (&acc)[2][2][4][2], const Unit& u, int wr, int wc, int fr, int fq) const {
        const int row0 = u.pm * BM + wr * 64 + fr, col0 = u.pn * BM + wc * 32 + 4 * fq;
#pragma unroll
        for (int ai = 0; ai < 2; ++ai)
#pragma unroll
            for (int m = 0; m < 4; ++m) { float* rowp = C + (size_t)(row0 + ai * HALF + m * 16) * ldc + col0;
#pragma unroll
                for (int bj = 0; bj < 2; ++bj)
#pragma unroll
                    for (int n = 0; n < 2; ++n) *(f32x4*)(rowp + bj * HALF + n * 16) = acc[ai][bj][m][n]; }
    }
};
struct EpiBf16 {
    static constexpr bool PERM = true, AFTER_DRAIN = false;
    __device__ __forceinline__ f32x4 init(const Unit&, int, int, int, int) const { return (f32x4){0.f, 0.f, 0.f, 0.f}; }
    bf16_t* O; int ldc; const float* bias; int bstride;
    __device__ __forceinline__ void operator()(const f32x4 (&acc)[2][2][4][2], const Unit& u, int wr, int wc, int fr, int fq) const {
        const int row0 = u.pm * BM + wr * 64 + fr; const int col0 = u.pn * BM + wc * 32 + 8 * fq;
        f32x4 bv[2][2];
#pragma unroll
        for (int bj = 0; bj < 2; ++bj)
#pragma unroll
            for (int n = 0; n < 2; ++n) bv[bj][n] = bias ? *(const f32x4*)(bias + (size_t)u.e * bstride + col0 + bj * HALF + 4 * n) : (f32x4){0.f, 0.f, 0.f, 0.f};
#pragma unroll
        for (int ai = 0; ai < 2; ++ai)
#pragma unroll
            for (int m = 0; m < 4; ++m) { bf16_t* rowp = O + (size_t)(row0 + ai * HALF + m * 16) * ldc + col0;
#pragma unroll
                for (int bj = 0; bj < 2; ++bj) { const f32x4 v0 = acc[ai][bj][m][0] + bv[bj][0], v1 = acc[ai][bj][m][1] + bv[bj][1];
                    u32x4 w; w.x = cvt_pk_bf16(v0[0], v0[1]); w.y = cvt_pk_bf16(v0[2], v0[3]); w.z = cvt_pk_bf16(v1[0], v1[1]); w.w = cvt_pk_bf16(v1[2], v1[3]);
                    *(u32x4*)(rowp + bj * HALF) = w; } }
    }
};
__device__ __forceinline__ unsigned pk4_fp8(float a, float b, float c, float d) { int w = 0; w = __builtin_amdgcn_cvt_pk_fp8_f32(a, b, w, false); w = __builtin_amdgcn_cvt_pk_fp8_f32(c, d, w, true); return (unsigned)w; }
struct EpiScatter {
    static constexpr bool PERM = true, AFTER_DRAIN = false;
    __device__ __forceinline__ f32x4 init(const Unit& u, int bj, int n, int wc, int fq) const { return *(const f32x4*)(bias + (size_t)u.e * 1024 + u.pn * BM + wc * 32 + 8 * fq + bj * HALF + 4 * n); }
    unsigned char* O; const float* bias; const int* map;
    __device__ __forceinline__ void operator()(const f32x4 (&acc)[2][2][4][2], const Unit& u, int wr, int wc, int fr, int fq) const {
        const int row0 = u.pm * BM + wr * 64 + fr; const int col0 = u.pn * BM + wc * 32 + 8 * fq;
        int dst[2][4];
#pragma unroll
        for (int ai = 0; ai < 2; ++ai)
#pragma unroll
            for (int m = 0; m < 4; ++m) dst[ai][m] = map[row0 + ai * HALF + m * 16];
        typedef unsigned u32x2 __attribute__((ext_vector_type(2)));
#pragma unroll
        for (int ai = 0; ai < 2; ++ai)
#pragma unroll
            for (int m = 0; m < 4; ++m) { if (dst[ai][m] < 0) continue; unsigned char* rowp = O + (size_t)dst[ai][m] * 1024 + col0;
#pragma unroll
                for (int bj = 0; bj < 2; ++bj) { const f32x4 v0 = acc[ai][bj][m][0] * 16.0f, v1 = acc[ai][bj][m][1] * 16.0f;
                    *(u32x2*)(rowp + bj * HALF) = (u32x2){pk4_fp8(v0[0], v0[1], v0[2], v0[3]), pk4_fp8(v1[0], v1[1], v1[2], v1[3])}; } }
    }
};
struct EpiSwiglu {
    static constexpr bool PERM = true, AFTER_DRAIN = false;
    __device__ __forceinline__ f32x4 init(const Unit&, int, int, int, int) const { return (f32x4){0.f, 0.f, 0.f, 0.f}; }
    bf16_t* O; const float* bias;
    __device__ __forceinline__ void operator()(const f32x4 (&acc)[2][2][4][2], const Unit& u, int wr, int wc, int fr, int fq) const {
        const int row0 = u.pm * BM + wr * 64 + fr; const int c0 = u.pn * HALF + wc * 32 + 8 * fq;
        f32x4 bg[2], bu[2];
#pragma unroll
        for (int n = 0; n < 2; ++n) { bg[n] = *(const f32x4*)(bias + (size_t)u.e * 2048 + c0 + 4 * n); bu[n] = *(const f32x4*)(bias + (size_t)u.e * 2048 + 1024 + c0 + 4 * n); }
#pragma unroll
        for (int ai = 0; ai < 2; ++ai)
#pragma unroll
            for (int m = 0; m < 4; ++m) { bf16_t* rowp = O + (size_t)(row0 + ai * HALF + m * 16) * 1024 + c0;
                float o[8];
#pragma unroll
                for (int n = 0; n < 2; ++n) { const f32x4 g4 = acc[ai][0][m][n] + bg[n], u4 = acc[ai][1][m][n] + bu[n];
#pragma unroll
                    for (int j = 0; j < 4; ++j) { const float g = fminf(g4[j], 7.0f), up = fminf(fmaxf(u4[j], -7.0f), 7.0f);
                        const float sg = __builtin_amdgcn_rcpf(1.0f + __builtin_amdgcn_exp2f(-1.702f * 1.44269504089f * g));
                        o[4 * n + j] = (up + 1.0f) * (g * sg); } }
                u32x4 w; w.x = cvt_pk_bf16(o[0], o[1]); w.y = cvt_pk_bf16(o[2], o[3]); w.z = cvt_pk_bf16(o[4], o[5]); w.w = cvt_pk_bf16(o[6], o[7]);
                *(u32x4*)rowp = w; }
    }
};

struct EpiSwiglu8 {
    static constexpr bool PERM = true, AFTER_DRAIN = false;
    __device__ __forceinline__ f32x4 init(const Unit& u, int bj, int n, int wc, int fq) const { return *(const f32x4*)(bias + (size_t)u.e * 2048 + bj * 1024 + u.pn * HALF + wc * 32 + 8 * fq + 4 * n); }
    unsigned char* O; const float* bias;
    __device__ __forceinline__ void operator()(const f32x4 (&acc)[2][2][4][2], const Unit& u, int wr, int wc, int fr, int fq) const {
        const int row0 = u.pm * BM + wr * 64 + fr; const int c0 = u.pn * HALF + wc * 32 + 8 * fq;
#pragma unroll
        for (int ai = 0; ai < 2; ++ai)
#pragma unroll
            for (int m = 0; m < 4; ++m) { unsigned char* rowp = O + (size_t)(row0 + ai * HALF + m * 16) * 1024 + c0;
                float o[8];
#pragma unroll
                for (int n = 0; n < 2; ++n) { const f32x4 g4 = acc[ai][0][m][n], u4 = acc[ai][1][m][n];
#pragma unroll
                    for (int j = 0; j < 4; ++j) { const float g = fminf(g4[j], 7.0f), up = fminf(fmaxf(u4[j], -7.0f), 7.0f);
                        const float sg = __builtin_amdgcn_rcpf(1.0f + __builtin_amdgcn_exp2f(-1.702f * 1.44269504089f * g));
                        o[4 * n + j] = (up + 1.0f) * (g * sg); } }
                typedef unsigned u32x2 __attribute__((ext_vector_type(2)));
                *(u32x2*)rowp = (u32x2){pk4_fp8(o[0], o[1], o[2], o[3]), pk4_fp8(o[4], o[5], o[6], o[7])}; }
    }
};

template <class Epi, class Sched, bool ALIGN_EPI = false, bool SP2 = false, bool FP8 = false, bool GATHER = false>
__device__ __forceinline__ void gemm_phase(PG8_LAS unsigned char* lds, const Gemm g, const Sched& S, const Epi& E) {
    const int tid = threadIdx.x, wid = __builtin_amdgcn_readfirstlane(tid >> 6), lane = tid & 63, wr = wid >> 2, wc = wid & 3, fr = lane & 15, fq = lane >> 4;
    const int K = g.K, nt = K / BK;
    unsigned vC[2][2], vN[2][2], voffB[2]; int Rr[2], Cb[2];
#pragma unroll
    for (int i = 0; i < 2; ++i) { int R, C; stage_rc(tid * 16 + i * 8192, R, C); const int Rb = Epi::PERM ? ((R & ~31) + perm32(R & 31)) : R; Rr[i] = R; Cb[i] = C * 2;
        voffB[i] = (unsigned)(Rb * K + C) * 2u;
#pragma unroll
        for (int h = 0; h < 2; ++h) { vC[h][i] = (unsigned)((HALF * h + R) * K + C) * 2u; vN[h][i] = vC[h][i]; } }
#define PG8_GOFF(dst, uix) do { if constexpr (GATHER) { _Pragma("unroll") for (int h_ = 0; h_ < 2; ++h_) _Pragma("unroll") for (int i_ = 0; i_ < 2; ++i_) \
        dst[h_][i_] = (unsigned)g.toklist[(uix) * 256 + HALF * h_ + Rr[i_]] * (unsigned)(K * 2) + (unsigned)Cb[i_]; } } while (0)
    const size_t kstep = (size_t)(BK * 2);
    const size_t hstep = (size_t)HALF * K * 2;
    const size_t tstep = 2 * hstep;
    const unsigned ldsw = (unsigned)wid * 1024u;
    constexpr int KSTR = 1024;
    const int aoff = lds_byte(wr * 64 + fr, fq * 8), boff = lds_byte(wc * 32 + fr, fq * 8);
#define PG8_SA(b, h) (((b) * 2 + (h)) * HTB)
#define PG8_SB(b, h) ((4 + (b) * 2 + (h)) * HTB)
#define PG8_STAGE(bufoff, gbase, voff) do { _Pragma("unroll") for (int _i = 0; _i < 2; ++_i) \
        __builtin_amdgcn_global_load_lds((const unsigned*)((const char*)(gbase) + (voff)[_i]), (PG8_LAS unsigned*)(lds + (bufoff) + ldsw + _i * 8192), 16, 0, 0); } while (0)
#define PG8_LDA(dst, b, h) do { _Pragma("unroll") for (int m = 0; m < 4; ++m) _Pragma("unroll") for (int k = 0; k < 2; ++k) dst[m][k] = *(const PG8_LAS bf16x8*)(lds + PG8_SA(b, h) + aoff + m * 2048 + k * KSTR); } while (0)
#define PG8_LDB(dst, b, h) do { _Pragma("unroll") for (int n = 0; n < 2; ++n) _Pragma("unroll") for (int k = 0; k < 2; ++k) dst[n][k] = *(const PG8_LAS bf16x8*)(lds + PG8_SB(b, h) + boff + n * 2048 + k * KSTR); } while (0)
#define PG8_MMA(ai, bj, At, Bt) do { __builtin_amdgcn_s_setprio(1); _Pragma("unroll") for (int m = 0; m < 4; ++m) _Pragma("unroll") for (int n = 0; n < 2; ++n) { \
        if constexpr (FP8) { acc[ai][bj][m][n] = __builtin_amdgcn_mfma_scale_f32_16x16x128_f8f6f4(cat8(Bt[n][0], Bt[n][1]), cat8(At[m][0], At[m][1]), acc[ai][bj][m][n], 0, 0, 0, g.scale_b, 0, g.scale_a); } \
        else { _Pragma("unroll") for (int k = 0; k < 2; ++k) acc[ai][bj][m][n] = __builtin_amdgcn_mfma_f32_16x16x32_bf16(Bt[n][k], At[m][k], acc[ai][bj][m][n], 0, 0, 0); } } \
        if constexpr (FP8) { _Pragma("unroll") for (int m = 0; m < 4; ++m) asm volatile("" : "+v"(acc[ai][bj][m][0]), "+v"(acc[ai][bj][m][1])); }     \
        __builtin_amdgcn_s_setprio(0); } while (0)
#define PG8_WAIT_V(n) asm volatile("s_waitcnt vmcnt(" #n ")" ::: "memory")
#define PG8_WAIT_L(n) asm volatile("s_waitcnt lgkmcnt(" #n ")" ::: "memory")
#define PG8_BAR __builtin_amdgcn_s_barrier()
#define PG8_SCHED __builtin_amdgcn_sched_barrier(0)
    Unit cur, nxt; int ui = 0;
    if (!S.next(0, cur)) return;
    f32x4 acc[2][2][4][2];
#pragma unroll
    for (int a = 0; a < 2; ++a)
#pragma unroll
        for (int b = 0; b < 2; ++b)
#pragma unroll
            for (int m = 0; m < 4; ++m)
#pragma unroll
                for (int n = 0; n < 2; ++n) acc[a][b][m][n] = E.init(cur, b, n, wc, fq);
    bf16x8 At[4][2], B0[2][2], B1[2][2];
    const char* cA = (const char*)g.A + (GATHER ? (size_t)0 : (size_t)(g.dry == 7 ? 0 : cur.pm) * tstep);
    PG8_GOFF(vC, 0); const char* cB = (const char*)g.Bt + (size_t)cur.e * g.estride + (size_t)cur.pn * tstep;
    S.a_ready(cur);
    if constexpr (SP2) {
        PG8_STAGE(PG8_SB(0, 0), cB, voffB); PG8_STAGE(PG8_SB(0, 1), cB + hstep, voffB); PG8_STAGE(PG8_SA(0, 0), cA, vC[0]); PG8_STAGE(PG8_SA(0, 1), cA, vC[1]);
        if (wr == 1) PG8_BAR;
        PG8_WAIT_V(2); PG8_BAR;
        PG8_STAGE(PG8_SB(1, 0), cB + kstep, voffB); PG8_STAGE(PG8_SA(1, 0), cA + kstep, vC[0]); PG8_STAGE(PG8_SB(1, 1), cB + hstep + kstep, voffB);
        PG8_WAIT_V(6); PG8_BAR;
    }
    for (;;) {
        const bool has_next = S.next(ui + 1, nxt);
        const char* nA = (has_next && !GATHER) ? (const char*)g.A + (size_t)(g.dry == 7 ? 0 : nxt.pm) * tstep : cA; const char* nB = has_next ? (const char*)g.Bt + (size_t)nxt.e * g.estride + (size_t)nxt.pn * tstep : cB;
        for (int t = 0; t < nt; t += 2) {
            const bool last = (t == nt - 2);
            const char* a1 = cA + (size_t)(t + 1) * kstep;
            const char* a2 = last ? nA : cA + (size_t)(t + 2) * kstep; const char* b2 = last ? nB : cB + (size_t)(t + 2) * kstep;
            const char* a3 = a2 + kstep; const char* b3 = b2 + kstep;
            if (last && has_next) { S.a_ready(nxt); PG8_GOFF(vN, ui + 1); }
            unsigned vX[2][2];
#pragma unroll
            for (int h_ = 0; h_ < 2; ++h_)
#pragma unroll
                for (int i_ = 0; i_ < 2; ++i_) vX[h_][i_] = (GATHER && last) ? vN[h_][i_] : vC[h_][i_];
            if constexpr (SP2) {
            PG8_LDB(B0, 0, 0); PG8_LDB(B1, 0, 1); PG8_SCHED; PG8_LDA(At, 0, 0); PG8_STAGE(PG8_SA(1, 1), a1, vC[1]);
            PG8_WAIT_V(8); PG8_WAIT_L(0); PG8_BAR; PG8_MMA(0, 0, At, B0); PG8_MMA(0, 1, At, B1); PG8_BAR; PG8_SCHED;
            PG8_LDA(At, 0, 1); PG8_STAGE(PG8_SB(0, 0), b2, voffB); PG8_STAGE(PG8_SB(0, 1), b2 + hstep, voffB); PG8_STAGE(PG8_SA(0, 0), a2, vX[0]);
            PG8_WAIT_V(8); PG8_WAIT_L(0); PG8_BAR; PG8_MMA(1, 0, At, B0); PG8_MMA(1, 1, At, B1); PG8_BAR; PG8_SCHED;
            PG8_LDB(B0, 1, 0); PG8_LDB(B1, 1, 1); PG8_SCHED; PG8_LDA(At, 1, 0); PG8_STAGE(PG8_SA(0, 1), a2, vX[1]);
            PG8_WAIT_V(8); PG8_WAIT_L(0); PG8_BAR; PG8_MMA(0, 0, At, B0); PG8_MMA(0, 1, At, B1); PG8_BAR; PG8_SCHED;
            PG8_LDA(At, 1, 1); PG8_STAGE(PG8_SB(1, 0), b3, voffB); PG8_STAGE(PG8_SB(1, 1), b3 + hstep, voffB); PG8_STAGE(PG8_SA(1, 0), a3, vX[0]);
            PG8_WAIT_V(8); PG8_WAIT_L(0); PG8_BAR; PG8_MMA(1, 0, At, B0); PG8_MMA(1, 1, At, B1); PG8_BAR; PG8_SCHED;
            }
        }
        if constexpr (ALIGN_EPI) { if (wr == 0) PG8_BAR; }
        if constexpr (!Epi::AFTER_DRAIN) { if (g.dry < 7) E(acc, cur, wr, wc, fr, fq); S.done(cur); }
        if (!has_next) break;
#pragma unroll
        for (int a = 0; a < 2; ++a)
#pragma unroll
            for (int b = 0; b < 2; ++b)
#pragma unroll
                for (int m = 0; m < 4; ++m)
#pragma unroll
                    for (int n = 0; n < 2; ++n) acc[a][b][m][n] = E.init(nxt, b, n, wc, fq);
        cur = nxt; cA = nA; cB = nB; ++ui;
        if constexpr (GATHER) {
#pragma unroll
            for (int h_ = 0; h_ < 2; ++h_)
#pragma unroll
                for (int i_ = 0; i_ < 2; ++i_) vC[h_][i_] = vN[h_][i_]; }
        if constexpr (ALIGN_EPI) { if (wr == 1) PG8_BAR; }
    }
    PG8_WAIT_V(0);
    if constexpr (!ALIGN_EPI) { if (wr == 0) PG8_BAR; }
    PG8_BAR;
    if constexpr (Epi::AFTER_DRAIN) { E.fused(acc, cur, wr, wc, fr, fq, lds, wid, lane); S.done(cur); }
#undef PG8_GOFF
#undef PG8_SA
#undef PG8_SB
#undef PG8_STAGE
#undef PG8_LDA
#undef PG8_LDB
#undef PG8_MMA
#undef PG8_WAIT_V
#undef PG8_WAIT_L
#undef PG8_BAR
#undef PG8_SCHED
}
}

constexpr int NB = 8, SEQ = 4096, D = 1024, T = NB * SEQ;
constexpr int DIN = 2464, DINP = 2560;
constexpr int NE = 32, TOPK = 4;
constexpr int NWAVES = 8, NTHR = 512;
constexpr float LN_EPS = 1e-5f, GN_EPS = 64e-5f, ALPHA = 1.189207115002721f;
constexpr int ROWS_PAD = T * TOPK + NE * 256;

constexpr size_t MiB = 1u << 20;
constexpr size_t WS_CTL = 0, CTL_ZERO_BYTES = 64 * 1024;
constexpr size_t WS_MOD = 1 * MiB;
constexpr size_t WS_TOKE = 1 * MiB + 256 * 1024;
constexpr size_t WS_TOKG = 1 * MiB + 768 * 1024;
constexpr size_t WS_SMAP = 12 * MiB;
constexpr size_t WS_WLT = 2 * MiB + 512 * 1024;
constexpr size_t WS_WIN = 3 * MiB;
constexpr size_t WS_WOUT = 8 * MiB;
constexpr size_t WS_ROT = 10 * MiB;
constexpr size_t WS_WGU = 16 * MiB;
constexpr size_t WS_STOK = 80 * MiB;
constexpr size_t WS_WDN = 144 * MiB;
constexpr size_t WS_H1 = 208 * MiB;
constexpr size_t WS_PROJ = 272 * MiB;
constexpr size_t WS_GF = 432 * MiB;
constexpr size_t WS_QF = 464 * MiB;
constexpr size_t WS_HT = 496 * MiB;
constexpr size_t WS_YL = 560 * MiB;
constexpr size_t WS_BV = 624 * MiB;
constexpr size_t WS_GG = 656 * MiB;
constexpr size_t WS_YRAW = 688 * MiB;
constexpr size_t WS_CAT = 752 * MiB;
constexpr size_t WS_YMIX = 816 * MiB;
constexpr size_t WS_X1 = 208 * MiB;
constexpr size_t WS_H2 = 336 * MiB;
constexpr size_t WS_XS = 400 * MiB;
constexpr size_t WS_ACT = 672 * MiB;
constexpr size_t WS_YB = 400 * MiB;
constexpr size_t WS_END = 944 * MiB;
constexpr int CW_BAR = 1024;
constexpr int CW_CNT = 12288;

constexpr int LDS_BYTES = 147456;
constexpr int MISC_OFF = 144384;

#define GAS __attribute__((address_space(1)))
#define LAS __attribute__((address_space(3)))
typedef unsigned short bf16;
typedef unsigned v4u __attribute__((ext_vector_type(4)));
typedef unsigned v2u __attribute__((ext_vector_type(2)));
typedef float f32x4 __attribute__((ext_vector_type(4)));
typedef float f32x2 __attribute__((ext_vector_type(2)));
typedef short bf16x8 __attribute__((ext_vector_type(8)));
#define LDS_WAIT() asm volatile("s_waitcnt lgkmcnt(0)" ::: "memory")
#define VM_WAIT() asm volatile("s_waitcnt vmcnt(0)" ::: "memory")
__device__ __forceinline__ unsigned f2bf(float f) { return pg8::cvt_pk_bf16(f, 0.f); }
__device__ __forceinline__ float bf2f(unsigned b) { return __builtin_bit_cast(float, b << 16); }
__device__ __forceinline__ unsigned pk2(float lo, float hi) { return pg8::cvt_pk_bf16(lo, hi); }
__device__ __forceinline__ float wave_sum(float v) {
#pragma unroll
    for (int o = 1; o < 64; o <<= 1) v += __shfl_xor(v, o);
    return v;
}
__device__ __forceinline__ float sigmoidf_(float x) { return __builtin_amdgcn_rcpf(1.0f + __expf(-x)); }
__device__ __forceinline__ float tanhf_(float x) { return 1.0f - 2.0f * __builtin_amdgcn_rcpf(1.0f + __expf(2.0f * x)); }
template <int CTRL> __device__ __forceinline__ float dpp_add(float v) { return v + __builtin_bit_cast(float, __builtin_amdgcn_update_dpp(0, __builtin_bit_cast(int, v), CTRL, 0xf, 0xf, true)); }
__device__ __forceinline__ float sum8(float v) { v = dpp_add<0xB1>(v); v = dpp_add<0x4E>(v); return dpp_add<0x141>(v); }
__device__ __forceinline__ float sum16(float v) { return dpp_add<0x140>(sum8(v)); }
__device__ __forceinline__ float rdl(float v, int l) { return __builtin_bit_cast(float, __builtin_amdgcn_readlane(__builtin_bit_cast(int, v), l)); }
__device__ __forceinline__ float wave_sum_u(float v) {
    v = sum16(v);
    v += __builtin_bit_cast(float, __builtin_amdgcn_update_dpp(0, __builtin_bit_cast(int, v), 0x142, 0xA, 0xF, false));
    v += __builtin_bit_cast(float, __builtin_amdgcn_update_dpp(0, __builtin_bit_cast(int, v), 0x143, 0xC, 0xF, false));
    return rdl(v, 63); }

#define XB_TMO      128
#define XB_XCNT(j)  (256  + 64 * (j))
#define XB_XSUB(j)  (1280 + 64 * (j))
#define XB_XGEN(j)  (2304 + 64 * (j))
#define XB_TOP      3328
#define XB_TOPGEN   3392
#define XCD_BAR_WORDS 3456
#define XB_SPIN_CAP (1u << 18)

__device__ __forceinline__ unsigned xb_ld(unsigned* p)              { return __hip_atomic_load(p, __ATOMIC_RELAXED, __HIP_MEMORY_SCOPE_AGENT); }
__device__ __forceinline__ unsigned xb_add(unsigned* p, unsigned v) { return __hip_atomic_fetch_add(p, v, __ATOMIC_RELAXED, __HIP_MEMORY_SCOPE_AGENT); }
__device__ __forceinline__ unsigned xb_xcc_id() { return (unsigned)__builtin_amdgcn_s_getreg((3 << 11) | 20) & 0xFu; }
#define XB_SPIN(cond, bar) do { unsigned _sp = 0; while (cond) { __builtin_amdgcn_s_sleep(1); \
    if ((++_sp & 255u) == 0u) { if (xb_ld(&(bar)[XB_TMO])) break; if (_sp > XB_SPIN_CAP) { atomicAdd(&(bar)[XB_TMO], 1u); break; } } } } while (0)

struct XcdBarrier {
    unsigned* bar; unsigned x;
    volatile LAS unsigned* st;
};
__device__ __forceinline__ XcdBarrier xcd_barrier_post(unsigned* bar, volatile LAS unsigned* st) {
    XcdBarrier b; b.bar = bar; b.x = xb_xcc_id(); b.st = st;
    if (threadIdx.x == 0) (void)xb_add(&bar[XB_XCNT(b.x)], 1u);
    return b;
}
__device__ __forceinline__ void xcd_barrier_complete(unsigned* bar, unsigned x, unsigned& nloc, unsigned& nx) {
    const unsigned G = gridDim.x * gridDim.y * gridDim.z;
    unsigned sum, cnt, mine, sp = 0u;
    for (;;) {
        sum = 0u; cnt = 0u; mine = 0u;
#pragma unroll
        for (unsigned j = 0; j < 16; ++j) { const unsigned c = xb_ld(&bar[XB_XCNT(j)]); sum += c; cnt += (c > 0u) ? 1u : 0u; mine = (j == x) ? c : mine; }
        if (sum == G) break;
        __builtin_amdgcn_s_sleep(1);
        if ((++sp & 255u) == 0u) { if (xb_ld(&bar[XB_TMO])) break; if (sp > XB_SPIN_CAP) { atomicAdd(&bar[XB_TMO], 1u); break; } }
    }
    nloc = mine > 0u ? mine : 1u; nx = cnt > 0u ? cnt : 1u;
}
__device__ __forceinline__ void xcd_barrier(const XcdBarrier& b) {
    asm volatile("s_waitcnt vmcnt(0)" ::: "memory");
    __syncthreads();
    if (threadIdx.x == 0) {
        unsigned* bar = b.bar;
        __builtin_amdgcn_s_waitcnt(0);
        unsigned nloc = b.st[0], nx = b.st[1];
        if (nloc == 0u) { xcd_barrier_complete(bar, b.x, nloc, nx); b.st[0] = nloc; b.st[1] = nx; }
        const unsigned old = xb_add(&bar[XB_XSUB(b.x)], 1u);
        const unsigned gen = old / nloc;
        if (old + 1u == (gen + 1u) * nloc) {
            __builtin_amdgcn_fence(__ATOMIC_RELEASE, "agent");
            asm volatile("s_waitcnt vmcnt(0)" ::: "memory");
            const unsigned og = xb_add(&bar[XB_TOP], 1u);
            const unsigned tg = og / nx;
            if (og + 1u == (tg + 1u) * nx) xb_add(&bar[XB_TOPGEN], 1u);
            else XB_SPIN(xb_ld(&bar[XB_TOPGEN]) == tg, bar);
            __builtin_amdgcn_fence(__ATOMIC_ACQUIRE, "agent");
            xb_add(&bar[XB_XGEN(b.x)], 1u);
            asm volatile("s_waitcnt vmcnt(0)" ::: "memory");
        } else {
            XB_SPIN(xb_ld(&bar[XB_XGEN(b.x)]) == gen, bar);
            __builtin_amdgcn_fence(__ATOMIC_ACQUIRE, "agent");
            asm volatile("s_waitcnt vmcnt(0)" ::: "memory");
        }
    }
    __syncthreads();
}

struct Args { const void* in[29]; float* out; unsigned char* ws; int ph_lo, ph_hi, li, pad; };
struct Frame {
    LAS unsigned char* lds;
    volatile LAS unsigned* MISC;
    unsigned* ctl;
    int tid, lane, wave, vcu, G;
};

__device__ __forceinline__ void p0_transpose_item(const float* W, int K, int N, bf16* WT, int k0, int n0, int orow0, LAS float* scr, int lane) {
#pragma unroll 8
    for (int i = 0; i < 32; ++i) { const int kk = 2 * i + (lane >> 5); scr[kk * 33 + (lane & 31)] = W[(size_t)(k0 + kk) * N + n0 + (lane & 31)]; }
    LDS_WAIT(); asm volatile("" ::: "memory");
    const int c = lane & 7;
#pragma unroll
    for (int j = 0; j < 4; ++j) { const int n = (lane >> 3) + 8 * j; const LAS float* s = scr + (8 * c) * 33 + n;
        v4u o; o.x = pk2(s[0 * 33], s[1 * 33]); o.y = pk2(s[2 * 33], s[3 * 33]); o.z = pk2(s[4 * 33], s[5 * 33]); o.w = pk2(s[6 * 33], s[7 * 33]);
        *(v4u*)(WT + (size_t)(orow0 + n) * K + k0 + 8 * c) = o; }
    LDS_WAIT(); asm volatile("" ::: "memory");
}
struct ConvRegs { f32x4 v[8]; };
__device__ __forceinline__ void conv_load8(ConvRegs& R, const float* W, int N, int k0, int n0, int lane) {
#pragma unroll
    for (int i = 0; i < 8; ++i) R.v[i] = *(const f32x4*)(W + (size_t)(k0 + i * 16 + (lane >> 2)) * N + n0 + 4 * (lane & 3));
}
__device__ __forceinline__ void conv_store8(const ConvRegs& R, int K, unsigned char* WT, int k0, int orow0, LAS float* scr, int lane, float sc) {
#pragma unroll
    for (int i = 0; i < 8; ++i)
#pragma unroll
        for (int j = 0; j < 4; ++j) scr[(4 * (lane & 3) + j) * 132 + i * 16 + (lane >> 2)] = R.v[i][j] * sc;
    LDS_WAIT(); asm volatile("" ::: "memory");
    const int n = lane >> 2, qd = lane & 3; const LAS f32x4* s4 = (const LAS f32x4*)(scr + n * 132 + qd * 32);
    v4u o[2];
#pragma unroll
    for (int h = 0; h < 2; ++h) { const f32x4 a0 = s4[4 * h], a1 = s4[4 * h + 1], a2 = s4[4 * h + 2], a3 = s4[4 * h + 3];
        o[h] = (v4u){pg8::pk4_fp8(a0[0], a0[1], a0[2], a0[3]), pg8::pk4_fp8(a1[0], a1[1], a1[2], a1[3]), pg8::pk4_fp8(a2[0], a2[1], a2[2], a2[3]), pg8::pk4_fp8(a3[0], a3[1], a3[2], a3[3])}; }
    v4u* dst = (v4u*)(WT + (size_t)(orow0 + n) * K + k0 + qd * 32); dst[0] = o[0]; dst[1] = o[1];
    LDS_WAIT(); asm volatile("" ::: "memory");
}
#define INF32(i) ((const float*)a.in[i])
__device__ __forceinline__ void p0_prologue(Frame& F, const Args& a) {
    unsigned char* ws = a.ws;
    if (blockIdx.x < 192) {
        const float* c_in = INF32(1); const float* w_ada = INF32(3); const float* b_ada = INF32(4);
        LAS float* sc = (LAS float*)F.lds;
        for (int i = F.tid; i < 8 * 1024; i += NTHR) { const float v = c_in[i]; sc[i] = v / (1.0f + expf(-v)); }
        __syncthreads();
        const int col = F.tid & 31, ks = F.tid >> 5, n = blockIdx.x * 32 + col;
        float acc[8];
#pragma unroll
        for (int b = 0; b < 8; ++b) acc[b] = 0.f;
#pragma unroll 16
        for (int k = ks * 64; k < ks * 64 + 64; ++k) { const float w = w_ada[(size_t)k * 6144 + n];
#pragma unroll
            for (int b = 0; b < 8; ++b) acc[b] += sc[b * 1024 + k] * w; }
        LAS float* red = (LAS float*)(F.lds + 32768);
#pragma unroll
        for (int b = 0; b < 8; ++b) red[(ks * 8 + b) * 32 + col] = acc[b];
        __syncthreads();
        if (F.tid < 256) { const int b = F.tid >> 5, cc = F.tid & 31, nn = blockIdx.x * 32 + cc; float s = b_ada[nn];
            for (int k2 = 0; k2 < 16; ++k2) s += red[(k2 * 8 + b) * 32 + cc];
            const int which = nn >> 10; if (which == 1 || which == 2 || which == 4 || which == 5) s += 1.0f;
            ((float*)(ws + WS_MOD))[b * 6144 + nn] = s; }
        __syncthreads();
    }
    LAS float* scr = (LAS float*)(F.lds + F.wave * 16384);
    const int gw = F.vcu * NWAVES + F.wave, NGW = F.G * NWAVES;
    constexpr int I_IN = 16 * 77, I_OUT = 16 * 32, NITEMS = I_IN + I_OUT;
    for (int it = gw; it < NITEMS; it += NGW) {
        int r = it;
        if (r < I_IN) { const int kb = r / 77, nb = r % 77;
            p0_transpose_item(INF32(5), 1024, DIN, (bf16*)(ws + WS_WIN), 64 * kb, 32 * nb, 32 * nb, scr, F.lane); continue; }
        r -= I_IN;
        { const int kb = r >> 5, nb = r & 31;
            p0_transpose_item(INF32(18), 1024, 1024, (bf16*)(ws + WS_WOUT), 64 * kb, 32 * nb, 32 * nb, scr, F.lane); }
    }
    for (int i = blockIdx.x * NTHR + F.tid; i < 512 * 160; i += F.G * NTHR) { const int hc2 = i / 160, kk = i - hc2 * 160;
        const float v = kk < 32 ? INF32(8)[kk * 512 + hc2] : (kk < 64 ? INF32(10)[(kk - 32) * 512 + hc2] : INF32(11)[(kk - 64) * 512 + hc2]);
        ((bf16*)(ws + WS_WLT))[i] = (bf16)f2bf(v); }
    {   const float INVF[8] = {1.0f, 0.1939227432012558f, 0.03760603070259094f, 0.007292664609849453f, 0.0014142135623842478f, 0.00027424818836152554f, 5.3182957344688475e-05f, 1.0313385246263351e-05f};
        const int* pos = (const int*)a.in[2]; float* ROT = (float*)(ws + WS_ROT);
        for (int i = blockIdx.x * NTHR + F.tid; i < T * 8; i += F.G * NTHR) { const int tok = i >> 3, fi = i & 7; float sn, cs; sincosf((float)pos[tok] * INVF[fi], &sn, &cs); ROT[tok * 16 + fi] = cs; ROT[tok * 16 + 8 + fi] = sn; } }
    { v4u* z = (v4u*)((bf16*)(ws + WS_WIN) + (size_t)DIN * 1024); const int nz = (DINP - DIN) * 1024 * 2 / 16;
      for (int i = blockIdx.x * NTHR + F.tid; i < nz; i += F.G * NTHR) z[i] = (v4u){0u, 0u, 0u, 0u}; }
}

constexpr int R2_CONV_ITEMS = 8 * 2048;
struct ConvDesc { const float* W; unsigned char* WT; int N, k0, n0, orow0; };
__device__ __forceinline__ ConvDesc moe_conv_desc(const Args& a, int h) {
    constexpr int I_GU = 32 * 8 * 64; ConvDesc d; const int it = h >> 1, hf = h & 1; int r = it;
    if (r < I_GU) { const int e = r >> 9, q = r & 511, kb = q >> 6, nb = q & 63, n0 = 32 * nb;
        const int orow0 = n0 < 1024 ? 256 * (n0 >> 7) + (n0 & 127) : 256 * ((n0 - 1024) >> 7) + 128 + ((n0 - 1024) & 127);
        d.W = INF32(23) + (size_t)e * 1024 * 2048; d.WT = a.ws + WS_WGU + (size_t)e * 2048 * 1024; d.N = 2048; d.k0 = 128 * kb; d.n0 = n0 + 16 * hf; d.orow0 = orow0 + 16 * hf; return d; }
    r -= I_GU;
    { const int e = r >> 8, q = r & 255, kb = q >> 5, nb = q & 31;
        d.W = INF32(25) + (size_t)e * 1024 * 1024; d.WT = a.ws + WS_WDN + (size_t)e * 1024 * 1024; d.N = 1024; d.k0 = 128 * kb; d.n0 = 32 * nb + 16 * hf; d.orow0 = 32 * nb + 16 * hf; return d; }
}
__device__ __forceinline__ void moe_weight_items(Frame& F, const Args& a, int gwi, int ngw, LAS float* scr) {
    constexpr int NH = 2 * (32 * 8 * 64 + 32 * 8 * 32);
    int it = gwi; if (it * 2 >= NH) return;
    ConvRegs RA, RB; ConvDesc dA = moe_conv_desc(a, 2 * it), dB = moe_conv_desc(a, 2 * it + 1);
    conv_load8(RA, dA.W, dA.N, dA.k0, dA.n0, F.lane); conv_load8(RB, dB.W, dB.N, dB.k0, dB.n0, F.lane);
#pragma unroll 1
    for (;;) { const int itn = it + ngw; const bool more = itn * 2 < NH;
        conv_store8(RA, 1024, dA.WT, dA.k0, dA.orow0, scr, F.lane, 32.0f);
        if (more) { dA = moe_conv_desc(a, 2 * itn); conv_load8(RA, dA.W, dA.N, dA.k0, dA.n0, F.lane); }
        conv_store8(RB, 1024, dB.WT, dB.k0, dB.orow0, scr, F.lane, 32.0f);
        if (!more) break;
        dB = moe_conv_desc(a, 2 * itn + 1); conv_load8(RB, dB.W, dB.N, dB.k0, dB.n0, F.lane);
        it = itn; }
}

__device__ __forceinline__ void p1_h1(Frame& F, const Args& a) {
    const float* x = INF32(0); const float* MOD = (const float*)(a.ws + WS_MOD); bf16* H1 = (bf16*)(a.ws + WS_H1);
    const int gw = F.vcu * NWAVES + F.wave, NGW = F.G * NWAVES;
    for (int m = gw; m < T; m += NGW) {
        const int b = m >> 12;
        const f32x4* xr = (const f32x4*)(x + (size_t)m * D) + F.lane;
        f32x4 v[4]; float s = 0.f;
#pragma unroll
        for (int j = 0; j < 4; ++j) { v[j] = xr[64 * j]; s += (v[j].x + v[j].y) + (v[j].z + v[j].w); }
        const float mean = wave_sum_u(s) * (1.f / D); float s2 = 0.f;
#pragma unroll
        for (int j = 0; j < 4; ++j) { v[j] = v[j] - mean; s2 += (v[j].x * v[j].x + v[j].y * v[j].y) + (v[j].z * v[j].z + v[j].w * v[j].w); }
        const float rstd = 1.f / sqrtf(wave_sum_u(s2) * (1.f / D) + LN_EPS);
        const f32x4* sh = (const f32x4*)(MOD + b * 6144) + F.lane; const f32x4* scl = (const f32x4*)(MOD + b * 6144 + 1024) + F.lane;
        v2u* o8 = (v2u*)(H1 + (size_t)m * D) + F.lane;
#pragma unroll
        for (int j = 0; j < 4; ++j) { const f32x4 o = v[j] * rstd * scl[64 * j] + sh[64 * j]; v2u w; w.x = pk2(o.x, o.y); w.y = pk2(o.z, o.w); o8[64 * j] = w; }
    }
}

__device__ __forceinline__ float bfel(const v4u& v, int e) { const unsigned w = v[e >> 1]; return (e & 1) ? __builtin_bit_cast(float, w & 0xffff0000u) : __builtin_bit_cast(float, w << 16); }
__device__ __forceinline__ void attn_unit(Frame& F, const Args& a, int unit) {
    const int kvh = unit & 1, qb = (unit >> 1) & 31, b = unit >> 6;
    const bf16* PROJ = (const bf16*)(a.ws + WS_PROJ); const float* ROT = (const float*)(a.ws + WS_ROT); bf16* CAT = (bf16*)(a.ws + WS_CAT);
    LAS unsigned char* Ks = F.lds;
    LAS unsigned char* VT = F.lds + 36864;
    const int tokq0 = b * SEQ + qb * 128, tokk0 = tokq0 - 128;
    const int fr = F.lane & 15, fq = F.lane >> 4;
    {
        const int row = F.tid >> 1, half = F.tid & 1, tk = tokk0 + row;
        const bool valid = (qb > 0) || (row >= 128);
        v4u kv[4], vv[4];
#pragma unroll
        for (int i = 0; i < 4; ++i) { kv[i] = (v4u){0u, 0u, 0u, 0u}; vv[i] = (v4u){0u, 0u, 0u, 0u}; }
        if (valid) { const v4u* kp = (const v4u*)(PROJ + (size_t)tk * DINP + 512 + kvh * 64 + half * 32); const v4u* vp = (const v4u*)(PROJ + (size_t)tk * DINP + 640 + kvh * 64 + half * 32);
#pragma unroll
            for (int i = 0; i < 4; ++i) { kv[i] = kp[i]; vv[i] = vp[i]; } }
        if (valid && half == 0) { const f32x4* rt = (const f32x4*)(ROT + (size_t)tk * 16); const f32x4 c0 = rt[0], c1 = rt[1], s0 = rt[2], s1 = rt[3]; float n1[8], n2[8];
#pragma unroll
            for (int i = 0; i < 8; ++i) { const float cs = i < 4 ? c0[i] : c1[i - 4], sn = i < 4 ? s0[i] : s1[i - 4]; const float t1 = bfel(kv[0], i), t2 = bfel(kv[1], i); n1[i] = t1 * cs - t2 * sn; n2[i] = t2 * cs + t1 * sn; }
            kv[0] = (v4u){pk2(n1[0], n1[1]), pk2(n1[2], n1[3]), pk2(n1[4], n1[5]), pk2(n1[6], n1[7])};
            kv[1] = (v4u){pk2(n2[0], n2[1]), pk2(n2[2], n2[3]), pk2(n2[4], n2[5]), pk2(n2[6], n2[7])}; }
        LAS v4u* kd = (LAS v4u*)(Ks + row * 144 + half * 64);
#pragma unroll
        for (int i = 0; i < 4; ++i) kd[i] = kv[i];
#pragma unroll
        for (int i = 0; i < 4; ++i)
#pragma unroll
            for (int e = 0; e < 8; ++e) { const unsigned w = vv[i][e >> 1]; *(LAS unsigned short*)(VT + (half * 32 + i * 8 + e) * 592 + row * 2) = (unsigned short)((e & 1) ? (w >> 16) : (w & 0xffffu)); }
        const int d = F.tid >> 3, part = F.tid & 7;
        *(LAS v2u*)(VT + d * 592 + 512 + part * 8) = (v2u){0u, 0u};
    }
    __syncthreads();
    const int g = F.wave & 3, qh = F.wave >> 2, hq = kvh * 4 + g;
    constexpr float LOG2E = 1.44269504089f;
    const float sink2 = INF32(17)[hq] * LOG2E;
    for (int mt = 0; mt < 4; ++mt) {
        const int i0 = qh * 64 + mt * 16, nlo = i0 >> 4, tq = tokq0 + i0 + fr;
        bf16x8 qf[2];
        {   const v4u* qp = (const v4u*)(PROJ + (size_t)tq * DINP + hq * 64 + 8 * fq); v4u q0 = qp[0], q1 = qp[4];
            const f32x4* rt = (const f32x4*)(ROT + (size_t)tq * 16); const f32x4 c0 = rt[0], c1 = rt[1], s0 = rt[2], s1 = rt[3];
            v4u pt; pt.x = __shfl_xor(q0.x, 16); pt.y = __shfl_xor(q0.y, 16); pt.z = __shfl_xor(q0.z, 16); pt.w = __shfl_xor(q0.w, 16);
            float nn[8];
#pragma unroll
            for (int i = 0; i < 8; ++i) { const float cs = i < 4 ? c0[i] : c1[i - 4], sn = i < 4 ? s0[i] : s1[i - 4]; const float own = bfel(q0, i), oth = bfel(pt, i);
                nn[i] = 0.125f * ((fq == 0) ? (own * cs - oth * sn) : ((fq == 1) ? (own * cs + oth * sn) : own)); }
            q0 = (v4u){pk2(nn[0], nn[1]), pk2(nn[2], nn[3]), pk2(nn[4], nn[5]), pk2(nn[6], nn[7])};
#pragma unroll
            for (int i = 0; i < 8; ++i) nn[i] = 0.125f * bfel(q1, i);
            q1 = (v4u){pk2(nn[0], nn[1]), pk2(nn[2], nn[3]), pk2(nn[4], nn[5]), pk2(nn[6], nn[7])};
            qf[0] = __builtin_bit_cast(bf16x8, q0); qf[1] = __builtin_bit_cast(bf16x8, q1); }
        f32x4 st[10];
#pragma unroll
        for (int r = 0; r < 9; ++r) { f32x4 acc = (f32x4){0.f, 0.f, 0.f, 0.f};
#pragma unroll
            for (int s = 0; s < 2; ++s) { const bf16x8 ka = *(const LAS bf16x8*)(Ks + (16 * (nlo + r) + fr) * 144 + (32 * s + 8 * fq) * 2); acc = __builtin_amdgcn_mfma_f32_16x16x32_bf16(ka, qf[s], acc, 0, 0, 0); }
            st[r] = acc; }
        st[9] = (f32x4){0.f, 0.f, 0.f, 0.f};
#pragma unroll
        for (int rg = 0; rg < 4; ++rg) { if (!(4 * fq + rg > fr)) st[0][rg] = -1e30f; if (!(4 * fq + rg <= fr)) st[8][rg] = -1e30f; }
        if (qb == 0) {
#pragma unroll
            for (int r = 0; r < 9; ++r) if (16 * (nlo + r) < 128) st[r] = (f32x4){-1e30f, -1e30f, -1e30f, -1e30f}; }
        float mx = -1e30f;
#pragma unroll
        for (int r = 0; r < 9; ++r) mx = fmaxf(mx, fmaxf(fmaxf(st[r][0], st[r][1]), fmaxf(st[r][2], st[r][3])));
        mx = fmaxf(mx, __shfl_xor(mx, 16)); mx = fmaxf(mx, __shfl_xor(mx, 32));
        const float m2 = fmaxf(mx * LOG2E, sink2);
        float l = 0.f;
#pragma unroll
        for (int r = 0; r < 9; ++r)
#pragma unroll
            for (int rg = 0; rg < 4; ++rg) { const float p = __builtin_amdgcn_exp2f(st[r][rg] * LOG2E - m2); st[r][rg] = p; l += p; }
        l += __shfl_xor(l, 16); l += __shfl_xor(l, 32); l += __builtin_amdgcn_exp2f(sink2 - m2);
        const float inv = 1.0f / l;
        bf16x8 pf[5];
#pragma unroll
        for (int ks = 0; ks < 5; ++ks) { const f32x4 p0 = st[2 * ks] * inv, p1 = st[2 * ks + 1] * inv;
            const v4u w = (v4u){pk2(p0[0], p0[1]), pk2(p0[2], p0[3]), pk2(p1[0], p1[1]), pk2(p1[2], p1[3])}; pf[ks] = __builtin_bit_cast(bf16x8, w); }
#pragma unroll
        for (int md = 0; md < 4; ++md) { f32x4 acc = (f32x4){0.f, 0.f, 0.f, 0.f};
#pragma unroll
            for (int ks = 0; ks < 5; ++ks) { const int kb = 16 * (nlo + 2 * ks) + 4 * fq; const LAS unsigned char* vp = VT + (16 * md + fr) * 592 + kb * 2;
                const v2u lo = *(const LAS v2u*)vp, hi = *(const LAS v2u*)(vp + 32); const v4u av = (v4u){lo.x, lo.y, hi.x, hi.y};
                acc = __builtin_amdgcn_mfma_f32_16x16x32_bf16(__builtin_bit_cast(bf16x8, av), pf[ks], acc, 0, 0, 0); }
            v2u w; w.x = pk2(acc[0], acc[1]); w.y = pk2(acc[2], acc[3]);
            *(v2u*)(CAT + (size_t)tq * 1024 + hq * 64 + 16 * md + 4 * fq) = w; }
    }
    __syncthreads();
}
constexpr int RS = 144, MSZ = 9216;
constexpr int L_AT = 0, L_BT = MSZ, L_KT = 2 * MSZ, L_RT = 3 * MSZ, L_BHT = 4 * MSZ, L_KHT = 5 * MSZ, L_VT = 6 * MSZ;
constexpr int L_MBRT = 7 * MSZ, L_MKRT = 8 * MSZ, L_WA = 9 * MSZ, L_XT = 10 * MSZ, L_UV = 11 * MSZ, L_LABTB = 12 * MSZ, L_LAKT = 13 * MSZ, L_LDIAG = 14 * MSZ, L_TJT = L_LDIAG + 4 * 16 * 17 * 4, L_R2END = L_TJT + 2048;
constexpr int L_LIN = 0, L_LW = 21504, L_LWP = 43008, L_LAP = 59648, LRS = 336;
static_assert(L_R2END <= MISC_OFF && L_LAP + 16640 <= MISC_OFF, "R2 LDS map");

__device__ __forceinline__ f32x4 mm64(const LAS unsigned char* A, const LAS unsigned char* B, int mt, int nt, int fr, int fq, f32x4 acc) {
#pragma unroll
    for (int s = 0; s < 2; ++s) { const bf16x8 av = *(const LAS bf16x8*)(A + (16 * mt + fr) * RS + (32 * s + 8 * fq) * 2); const bf16x8 bv = *(const LAS bf16x8*)(B + (16 * nt + fr) * RS + (32 * s + 8 * fq) * 2);
        acc = __builtin_amdgcn_mfma_f32_16x16x32_bf16(av, bv, acc, 0, 0, 0); }
    return acc;
}
__device__ __forceinline__ float softplusf_(float x) { return fmaxf(x, 0.f) + __logf(1.0f + __expf(-fabsf(x))); }

struct R2Raw { v4u cur[3], prv[3]; unsigned short r[9], k[9], v[9]; };
__device__ __forceinline__ void r2_load(R2Raw& R, const Frame& F, const Args& a, int ch, bool codes) {
    const int c = ch & 63, bh = ch >> 6, h = bh & 7, b = bh >> 3, tok0 = b * SEQ + c * 64;
    const bf16* PROJ = (const bf16*)(a.ws + WS_PROJ);
#pragma unroll
    for (int i = 0; i < 3; ++i) { const int item = F.tid + 512 * i; const int t = item / 20, q = item - t * 20;
        if (codes && item < 1280) { R.cur[i] = *(const v4u*)(PROJ + (size_t)(tok0 + t) * DINP + 2304 + 8 * q);
            R.prv[i] = (c == 0 && t == 0) ? (v4u){0u, 0u, 0u, 0u} : *(const v4u*)(PROJ + (size_t)(tok0 + t - 1) * DINP + 2304 + 8 * q); } }
    const int tg = F.wave, hc = h * 64 + F.lane; const bool hasprev = !(c == 0 && tg == 0);
#pragma unroll
    for (int u = 0; u < 9; ++u) { const size_t row = (size_t)(tok0 + 8 * tg + u - 1) * DINP; const bool ok = (u > 0) || hasprev;
        R.r[u] = ok ? PROJ[row + 768 + hc] : (unsigned short)0; R.k[u] = ok ? PROJ[row + 1280 + hc] : (unsigned short)0; R.v[u] = ok ? PROJ[row + 1792 + hc] : (unsigned short)0; }
}
__device__ __forceinline__ void r2_unit(Frame& F, const Args& a, int ch, R2Raw& R, int ch_next, bool next_first, bool first, v4u (&lin)[3]) {
    const int c = ch & 63, bh = ch >> 6, h = bh & 7, b = bh >> 3, tok0 = b * SEQ + c * 64;
    const bf16* PROJ = (const bf16*)(a.ws + WS_PROJ);
    const float* mu = INF32(6);
    LAS unsigned char* L = F.lds;
    LAS float* pc = (LAS float*)(F.lds + MISC_OFF + 256);
    LAS float* tot = (LAS float*)(F.lds + MISC_OFF + 512);
    const int fr = F.lane & 15, fq = F.lane >> 4;
    const f32x4 Z4 = (f32x4){0.f, 0.f, 0.f, 0.f};
    {   v4u wv[3];
#pragma unroll
        for (int i = 0; i < 3; ++i) { const int item = F.tid + 512 * i; if (item < 1280) wv[i] = *(const v4u*)((const bf16*)(a.ws + WS_WLT) + (size_t)h * 64 * 160 + (size_t)item * 8); }
#pragma unroll
        for (int i = 0; i < 3; ++i) { const int item = F.tid + 512 * i; const int t = item / 20, q = item - t * 20;
            if (item < 1280) {
                if (first) { const f32x4 m0 = *(const f32x4*)(mu + 1536 + 8 * q), m1 = *(const f32x4*)(mu + 1536 + 8 * q + 4); float o[8];
                    const float km = q < 4 ? 2.0f : 1.0f, ka = q < 4 ? 2.0f : 1.0f, kb = q < 4 ? -1.0f : 0.0f; const bool lnr = (q >= 4 && q < 8);
#pragma unroll
                    for (int e = 0; e < 8; ++e) { const float cv = bfel(R.cur[i], e), pv = bfel(R.prv[i], e); const float v = cv + (pv - cv) * (e < 4 ? m0[e] : m1[e - 4]);
                        const float sg = sigmoidf_(km * v); o[e] = lnr ? v : ka * sg + kb; }
                    lin[i] = (v4u){pk2(o[0], o[1]), pk2(o[2], o[3]), pk2(o[4], o[5]), pk2(o[6], o[7])}; }
                *(LAS v4u*)(L + L_LIN + t * LRS + q * 16) = lin[i];
                *(LAS v4u*)(L + L_LW + t * LRS + q * 16) = wv[i]; } } }
    const int tg = F.wave, cc = F.lane, hc = h * 64 + cc;
    float rr[8], kx[8], vv[8];
    {   const float mr = mu[hc], mk = mu[512 + hc], mv = mu[1024 + hc];
#pragma unroll
        for (int u = 0; u < 8; ++u) { const float pr = bf2f(R.r[u]), cr = bf2f(R.r[u + 1]), pk_ = bf2f(R.k[u]), ck = bf2f(R.k[u + 1]), pv = bf2f(R.v[u]), cv = bf2f(R.v[u + 1]);
            rr[u] = cr + (pr - cr) * mr; kx[u] = ck + (pk_ - ck) * mk; vv[u] = cv + (pv - cv) * mv; } }
    __syncthreads();
    {   const int mt = F.wave >> 1; bf16x8 af[5];
#pragma unroll
        for (int s = 0; s < 5; ++s) af[s] = *(const LAS bf16x8*)(L + L_LIN + (16 * mt + fr) * LRS + (32 * s + 8 * fq) * 2);
        bf16* GG = (bf16*)(a.ws + WS_GG);
#pragma unroll
        for (int ni = 0; ni < 2; ++ni) { const int nt = 2 * (F.wave & 1) + ni; bf16x8 bfr[5];
#pragma unroll
            for (int s = 0; s < 5; ++s) bfr[s] = *(const LAS bf16x8*)(L + L_LW + (16 * nt + fr) * LRS + (32 * s + 8 * fq) * 2);
            const f32x4 dw = __builtin_amdgcn_mfma_f32_16x16x32_bf16(af[0], bfr[0], Z4, 0, 0, 0), da = __builtin_amdgcn_mfma_f32_16x16x32_bf16(af[1], bfr[1], Z4, 0, 0, 0);
            f32x4 dg = __builtin_amdgcn_mfma_f32_16x16x32_bf16(af[2], bfr[2], Z4, 0, 0, 0); dg = __builtin_amdgcn_mfma_f32_16x16x32_bf16(af[3], bfr[3], dg, 0, 0, 0); dg = __builtin_amdgcn_mfma_f32_16x16x32_bf16(af[4], bfr[4], dg, 0, 0, 0);
#pragma unroll
            for (int rg = 0; rg < 4; ++rg) { const int t = 16 * mt + 4 * fq + rg, cch = 16 * nt + fr;
                *(LAS float*)(L + L_LWP + (t * 65 + cch) * 4) = dw[rg]; *(LAS float*)(L + L_LAP + (t * 65 + cch) * 4) = da[rg];
                if (a.pad < 11) GG[(size_t)(tok0 + t) * 512 + h * 64 + cch] = (bf16)f2bf(dg[rg]); } } }
    __syncthreads();
    float ld[8], av[8], bv[8];
    {   const float kkw = INF32(12)[hc], kaw = INF32(13)[hc], rkw = INF32(14)[hc], w0 = INF32(7)[hc], a0 = INF32(9)[hc];
        bf16* BV = (bf16*)(a.ws + WS_BV);
        float al[8], sm[16];
#pragma unroll
        for (int u = 0; u < 8; ++u) { const int t = 8 * tg + u;
            const float wpv = *(const LAS float*)(L + L_LWP + (t * 65 + cc) * 4) + w0, apv = *(const LAS float*)(L + L_LAP + (t * 65 + cc) * 4) + a0;
            ld[u] = -0.6065306597126334f * sigmoidf_(wpv);
            al[u] = sigmoidf_(apv); }
#pragma unroll
        for (int u = 0; u < 8; ++u) { const float kk = kx[u] * kkw; av[u] = kk; sm[u] = kk * kk; kx[u] = kx[u] * (1.0f + (al[u] - 1.0f) * kaw); sm[8 + u] = rr[u] * kx[u] * rkw; }
#pragma unroll
        for (int i = 0; i < 16; ++i) sm[i] = dpp_add<0xB1>(sm[i]);
#pragma unroll
        for (int i = 0; i < 16; ++i) sm[i] = dpp_add<0x4E>(sm[i]);
#pragma unroll
        for (int i = 0; i < 16; ++i) sm[i] = dpp_add<0x141>(sm[i]);
#pragma unroll
        for (int i = 0; i < 16; ++i) sm[i] = dpp_add<0x140>(sm[i]);
#pragma unroll
        for (int i = 0; i < 16; ++i) sm[i] += __builtin_bit_cast(float, __builtin_amdgcn_update_dpp(0, __builtin_bit_cast(int, sm[i]), 0x142, 0xA, 0xF, false));
#pragma unroll
        for (int i = 0; i < 16; ++i) sm[i] += __builtin_bit_cast(float, __builtin_amdgcn_update_dpp(0, __builtin_bit_cast(int, sm[i]), 0x143, 0xC, 0xF, false));
#pragma unroll
        for (int i = 0; i < 16; ++i) sm[i] = rdl(sm[i], 63);
#pragma unroll
        for (int u = 0; u < 8; ++u) { const float kk = av[u] * __builtin_amdgcn_rcpf(fmaxf(sqrtf(sm[u]), 1e-12f)); av[u] = -kk; bv[u] = kk * al[u];
            if (a.pad < 11) BV[(size_t)(tok0 + 8 * tg + u) * 512 + hc] = (bf16)f2bf(sm[8 + u] * vv[u]); } }
    float cs[8]; { float run = 0.f;
#pragma unroll
        for (int u = 0; u < 8; ++u) { run += ld[u]; cs[u] = run; }
        tot[tg * 64 + cc] = run; }
    __syncthreads();
    float off = 0.f, csl = 0.f;
#pragma unroll
    for (int g2i = 0; g2i < 8; ++g2i) { const float tv = tot[g2i * 64 + cc]; off += (g2i < tg) ? tv : 0.f; csl += tv; }
    const float ecsl = __expf(csl);
    if (tg == 0) pc[cc] = ecsl;
    {   unsigned pb[4], pkk[4], pvv[4];
#pragma unroll
        for (int u2 = 0; u2 < 4; ++u2) { float xa[2], xb[2], xk[2], xr[2], hb[2], hk[2];
#pragma unroll
            for (int p = 0; p < 2; ++p) { const int u = 2 * u2 + p; const float ci = cs[u] + off, cx = ci - ld[u];
                const float eneg = __expf(-ci), epos = __builtin_amdgcn_rcpf(eneg), eh = ecsl * eneg;
                xa[p] = av[u] * __expf(cx); xb[p] = bv[u] * eneg; xk[p] = kx[u] * eneg; xr[p] = rr[u] * epos; hb[p] = bv[u] * eh; hk[p] = kx[u] * eh; }
            const int t = 8 * tg + 2 * u2; const unsigned wa = pk2(xa[0], xa[1]), wb = pk2(xb[0], xb[1]), wk = pk2(xk[0], xk[1]), wr_ = pk2(xr[0], xr[1]);
            *(LAS unsigned short*)(L + L_AT + t * RS + cc * 2) = (unsigned short)wa; *(LAS unsigned short*)(L + L_AT + (t + 1) * RS + cc * 2) = (unsigned short)(wa >> 16);
            *(LAS unsigned short*)(L + L_BT + t * RS + cc * 2) = (unsigned short)wb; *(LAS unsigned short*)(L + L_BT + (t + 1) * RS + cc * 2) = (unsigned short)(wb >> 16);
            *(LAS unsigned short*)(L + L_KT + t * RS + cc * 2) = (unsigned short)wk; *(LAS unsigned short*)(L + L_KT + (t + 1) * RS + cc * 2) = (unsigned short)(wk >> 16);
            *(LAS unsigned short*)(L + L_RT + t * RS + cc * 2) = (unsigned short)wr_; *(LAS unsigned short*)(L + L_RT + (t + 1) * RS + cc * 2) = (unsigned short)(wr_ >> 16);
            pb[u2] = pk2(hb[0], hb[1]); pkk[u2] = pk2(hk[0], hk[1]); pvv[u2] = pk2(vv[2 * u2], vv[2 * u2 + 1]); }
        *(LAS v4u*)(L + L_BHT + cc * RS + 16 * tg) = (v4u){pb[0], pb[1], pb[2], pb[3]};
        *(LAS v4u*)(L + L_KHT + cc * RS + 16 * tg) = (v4u){pkk[0], pkk[1], pkk[2], pkk[3]};
        *(LAS v4u*)(L + L_VT + cc * RS + 16 * tg) = (v4u){pvv[0], pvv[1], pvv[2], pvv[3]}; }
    __syncthreads();
    if (a.pad == 12) return;
    const int nt_ = F.wave & 3, mp = F.wave >> 2;
#pragma unroll
    for (int mi = 0; mi < 2; ++mi) { const int mt = 2 * mp + mi; const int tcol = 16 * nt_ + fr, j0 = 16 * mt + 4 * fq;
        f32x4 d1 = mm64(L + L_BT, L + L_AT, mt, nt_, fr, fq, Z4), d2 = mm64(L + L_KT, L + L_AT, mt, nt_, fr, fq, Z4);
        f32x4 d3 = mm64(L + L_BT, L + L_RT, mt, nt_, fr, fq, Z4), d4 = mm64(L + L_KT, L + L_RT, mt, nt_, fr, fq, Z4);
#pragma unroll
        for (int rg = 0; rg < 4; ++rg) { const bool lt = (j0 + rg < tcol), le = (j0 + rg <= tcol); d1[rg] = lt ? d1[rg] : 0.f; d2[rg] = lt ? d2[rg] : 0.f; d3[rg] = le ? d3[rg] : 0.f; d4[rg] = le ? d4[rg] : 0.f; }
        *(LAS v2u*)(L + L_LABTB + tcol * RS + j0 * 2) = (v2u){pk2(d1[0], d1[1]), pk2(d1[2], d1[3])};
        *(LAS v2u*)(L + L_LAKT + tcol * RS + j0 * 2) = (v2u){pk2(d2[0], d2[1]), pk2(d2[2], d2[3])};
        *(LAS v2u*)(L + L_MBRT + tcol * RS + j0 * 2) = (v2u){pk2(d3[0], d3[1]), pk2(d3[2], d3[3])};
        *(LAS v2u*)(L + L_MKRT + tcol * RS + j0 * 2) = (v2u){pk2(d4[0], d4[1]), pk2(d4[2], d4[3])};
        if (mt == nt_) {
#pragma unroll
            for (int rg = 0; rg < 4; ++rg) *(LAS float*)(L + L_LDIAG + ((mt * 16 + fr) * 17 + 4 * fq + rg) * 4) = d1[rg]; } }
    __syncthreads();
    {   const int rho = F.tid >> 3, sub = F.tid & 7, J = rho >> 4, i = rho & 15; const LAS float* dg = (const LAS float*)(L + L_LDIAG) + J * 16 * 17;
        float t0 = 0.f, t1 = 0.f;
#pragma unroll
        for (int m = 0; m < 16; ++m) { const float p = sum8(t0 * dg[m * 17 + sub] + t1 * dg[m * 17 + sub + 8]); const float tm = p + ((m == i) ? 1.f : 0.f);
            if (m < 8) { t0 = (sub == m) ? tm : t0; } else { t1 = (sub + 8 == m) ? tm : t1; } }
        *(LAS unsigned short*)(L + L_TJT + J * 512 + sub * 32 + i * 2) = (unsigned short)f2bf(t0);
        *(LAS unsigned short*)(L + L_TJT + J * 512 + (sub + 8) * 32 + i * 2) = (unsigned short)f2bf(t1); }
    __syncthreads();
    if (ch_next >= 0) r2_load(R, F, a, ch_next, next_first);
    {   const int r = 16 * (F.wave & 3) + fr; const LAS unsigned char* RH = L + (F.wave < 4 ? L_AT : L_LAKT); v2u zb[4];
#pragma unroll
        for (int J = 0; J < 4; ++J) { f32x4 acc;
#pragma unroll
            for (int rg = 0; rg < 4; ++rg) acc[rg] = bf2f(*(const LAS unsigned short*)(RH + (16 * J + 4 * fq + rg) * RS + r * 2));
            if (J >= 1) { const v2u lo = *(const LAS v2u*)(L + L_LABTB + (16 * J + fr) * RS + (4 * fq) * 2); v2u hi = (v2u){0u, 0u}, zh = (v2u){0u, 0u};
                if (J >= 2) { hi = *(const LAS v2u*)(L + L_LABTB + (16 * J + fr) * RS + (16 + 4 * fq) * 2); zh = zb[1]; }
                acc = __builtin_amdgcn_mfma_f32_16x16x32_bf16(__builtin_bit_cast(bf16x8, (v4u){lo.x, lo.y, hi.x, hi.y}), __builtin_bit_cast(bf16x8, (v4u){zb[0].x, zb[0].y, zh.x, zh.y}), acc, 0, 0, 0); }
            if (J == 3) { const v2u lo = *(const LAS v2u*)(L + L_LABTB + (48 + fr) * RS + (32 + 4 * fq) * 2);
                acc = __builtin_amdgcn_mfma_f32_16x16x32_bf16(__builtin_bit_cast(bf16x8, (v4u){lo.x, lo.y, 0u, 0u}), __builtin_bit_cast(bf16x8, (v4u){zb[2].x, zb[2].y, 0u, 0u}), acc, 0, 0, 0); }
            const v2u tj = *(const LAS v2u*)(L + L_TJT + J * 512 + fr * 32 + (4 * fq) * 2);
            const f32x4 z = __builtin_amdgcn_mfma_f32_16x16x32_bf16(__builtin_bit_cast(bf16x8, (v4u){tj.x, tj.y, 0u, 0u}), __builtin_bit_cast(bf16x8, (v4u){pk2(acc[0], acc[1]), pk2(acc[2], acc[3]), 0u, 0u}), Z4, 0, 0, 0);
            zb[J] = (v2u){pk2(z[0], z[1]), pk2(z[2], z[3])};
            if (F.wave < 4) *(LAS v2u*)(L + L_WA + r * RS + (16 * J + 4 * fq) * 2) = zb[J];
            else {
#pragma unroll
                for (int rg = 0; rg < 4; ++rg) *(LAS unsigned short*)(L + L_XT + (16 * J + 4 * fq + rg) * RS + r * 2) = (unsigned short)f2bf(z[rg]); } } }
    __syncthreads();
    if (a.pad == 13) return;
#pragma unroll
    for (int mi = 0; mi < 2; ++mi) { const int mt = 2 * mp + mi; const f32x4 d = mm64(L + L_XT, L + L_VT, mt, nt_, fr, fq, Z4);
        *(LAS v2u*)(L + L_UV + (16 * nt_ + fr) * RS + (16 * mt + 4 * fq) * 2) = (v2u){pk2(d[0], d[1]), pk2(d[2], d[3])}; }
    __syncthreads();
    {   f32x4 g0 = mm64(L + L_WA, L + L_BHT, 2 * mp, nt_, fr, fq, Z4), g1 = mm64(L + L_WA, L + L_BHT, 2 * mp + 1, nt_, fr, fq, Z4);
        if (2 * mp == nt_) {
#pragma unroll
            for (int rg = 0; rg < 4; ++rg) if (4 * fq + rg == fr) g0[rg] += pc[16 * nt_ + fr]; }
        if (2 * mp + 1 == nt_) {
#pragma unroll
            for (int rg = 0; rg < 4; ++rg) if (4 * fq + rg == fr) g1[rg] += pc[16 * nt_ + fr]; }
        v4u* GF = (v4u*)(a.ws + WS_GF) + (size_t)ch * 512 + (nt_ * 2 + mp) * 64 + F.lane;
        if (a.pad < 11) *GF = (v4u){pk2(g0[0], g0[1]), pk2(g0[2], g0[3]), pk2(g1[0], g1[1]), pk2(g1[2], g1[3])};
        f32x4 q0 = mm64(L + L_WA, L + L_MBRT, 2 * mp, nt_, fr, fq, Z4), q1 = mm64(L + L_WA, L + L_MBRT, 2 * mp + 1, nt_, fr, fq, Z4);
#pragma unroll
        for (int rg = 0; rg < 4; ++rg) { const int tcol = 16 * nt_ + fr;
            q0[rg] += bf2f(*(const LAS unsigned short*)(L + L_RT + tcol * RS + (32 * mp + 4 * fq + rg) * 2));
            q1[rg] += bf2f(*(const LAS unsigned short*)(L + L_RT + tcol * RS + (32 * mp + 16 + 4 * fq + rg) * 2)); }
        v4u* QF = (v4u*)(a.ws + WS_QF) + (size_t)ch * 512 + (nt_ * 2 + mp) * 64 + F.lane;
        if (a.pad < 11) *QF = (v4u){pk2(q0[0], q0[1]), pk2(q0[2], q0[3]), pk2(q1[0], q1[1]), pk2(q1[2], q1[3])};
        f32x4 hh[2], yy[2];
#pragma unroll
        for (int mi = 0; mi < 2; ++mi) { const int mt = 2 * mp + mi;
            hh[mi] = mm64(L + L_BHT, L + L_UV, mt, nt_, fr, fq, Z4); hh[mi] = mm64(L + L_KHT, L + L_VT, mt, nt_, fr, fq, hh[mi]);
            yy[mi] = mm64(L + L_MBRT, L + L_UV, mt, nt_, fr, fq, Z4); yy[mi] = mm64(L + L_MKRT, L + L_VT, mt, nt_, fr, fq, yy[mi]); }
        if (a.pad < 11) ((v4u*)(a.ws + WS_HT))[(size_t)ch * 512 + (nt_ * 2 + mp) * 64 + F.lane] = (v4u){pk2(hh[0][0], hh[0][1]), pk2(hh[0][2], hh[0][3]), pk2(hh[1][0], hh[1][1]), pk2(hh[1][2], hh[1][3])};
        if (a.pad < 11) ((v4u*)(a.ws + WS_YL))[(size_t)ch * 512 + (nt_ * 2 + mp) * 64 + F.lane] = (v4u){pk2(yy[0][0], yy[0][1]), pk2(yy[0][2], yy[0][3]), pk2(yy[1][0], yy[1][1]), pk2(yy[1][2], yy[1][3])}; }
    __syncthreads();
}

constexpr int R3_RING = 61440, R3_SLOT = 20480;
static_assert(R3_RING + 3 * R3_SLOT <= MISC_OFF && 7 * 8448 <= R3_RING, "scan-phase LDS map");
__device__ __forceinline__ void r3_scan(Frame& F, const Args& a) {
    if (F.wave != 0) { if (a.pad == 3) return; moe_weight_items(F, a, F.vcu * 7 + F.wave - 1, F.G * 7, (LAS float*)(F.lds + (F.wave - 1) * 8448)); return; }
    if (F.vcu >= 256 || a.pad == 4) return;
    const int bh = F.vcu >> 2, vg = F.vcu & 3;
    const unsigned char* GFb = a.ws + WS_GF + (size_t)bh * 64 * 8192 + F.lane * 16; const unsigned char* QFb = a.ws + WS_QF + (size_t)bh * 64 * 8192 + F.lane * 16;
    const unsigned char* HTb = a.ws + WS_HT + ((size_t)bh * 64 * 8 + vg * 2) * 1024 + F.lane * 16; const unsigned char* YLb = a.ws + WS_YL + ((size_t)bh * 64 * 8 + vg * 2) * 1024 + F.lane * 16;
    v4u* YT = (v4u*)(a.ws + WS_YRAW) + ((size_t)bh * 64 * 4 + vg) * 2 * 64 + F.lane;
    LAS unsigned char* ring = F.lds + R3_RING;
#define R3_ISSUE(cc) do { const int c_ = (cc) < 63 ? (cc) : 63; LAS unsigned char* sl_ = ring + ((cc) % 3) * R3_SLOT; \
        _Pragma("unroll") for (int i = 0; i < 8; ++i) __builtin_amdgcn_global_load_lds((const unsigned*)(GFb + (size_t)c_ * 8192 + i * 1024), (LAS unsigned*)(sl_ + i * 1024), 16, 0, 0); \
        _Pragma("unroll") for (int i = 0; i < 8; ++i) __builtin_amdgcn_global_load_lds((const unsigned*)(QFb + (size_t)c_ * 8192 + i * 1024), (LAS unsigned*)(sl_ + 8192 + i * 1024), 16, 0, 0); \
        _Pragma("unroll") for (int i = 0; i < 2; ++i) __builtin_amdgcn_global_load_lds((const unsigned*)(HTb + (size_t)c_ * 8192 + i * 1024), (LAS unsigned*)(sl_ + 16384 + i * 1024), 16, 0, 0); \
        _Pragma("unroll") for (int i = 0; i < 2; ++i) __builtin_amdgcn_global_load_lds((const unsigned*)(YLb + (size_t)c_ * 8192 + i * 1024), (LAS unsigned*)(sl_ + 18432 + i * 1024), 16, 0, 0); } while (0)
    f32x4 S[4];
#pragma unroll
    for (int m = 0; m < 4; ++m) S[m] = (f32x4){0.f, 0.f, 0.f, 0.f};
    R3_ISSUE(0); R3_ISSUE(1);
    for (int c = 0; c < 64; ++c) {
        R3_ISSUE(c + 2);
        asm volatile("s_waitcnt vmcnt(40)" ::: "memory");
        const LAS unsigned char* sl = ring + (c % 3) * R3_SLOT + F.lane * 16;
        v4u gfr[8], qfr[8]; f32x4 ht[4], yl[4];
#pragma unroll
        for (int i = 0; i < 8; ++i) { gfr[i] = *(const LAS v4u*)(sl + i * 1024); qfr[i] = *(const LAS v4u*)(sl + 8192 + i * 1024); }
#pragma unroll
        for (int i = 0; i < 2; ++i) { const v4u hv = *(const LAS v4u*)(sl + 16384 + i * 1024), yv = *(const LAS v4u*)(sl + 18432 + i * 1024);
            ht[2 * i] = (f32x4){bf2f(hv.x & 0xffffu), bf2f(hv.x >> 16), bf2f(hv.y & 0xffffu), bf2f(hv.y >> 16)}; ht[2 * i + 1] = (f32x4){bf2f(hv.z & 0xffffu), bf2f(hv.z >> 16), bf2f(hv.w & 0xffffu), bf2f(hv.w >> 16)};
            yl[2 * i] = (f32x4){bf2f(yv.x & 0xffffu), bf2f(yv.x >> 16), bf2f(yv.y & 0xffffu), bf2f(yv.y >> 16)}; yl[2 * i + 1] = (f32x4){bf2f(yv.z & 0xffffu), bf2f(yv.z >> 16), bf2f(yv.w & 0xffffu), bf2f(yv.w >> 16)}; }
        bf16x8 bhi[2], blo[2];
#pragma unroll
        for (int s = 0; s < 2; ++s) { float hi[8], lo[8];
#pragma unroll
            for (int j = 0; j < 8; ++j) { const float v = S[2 * s + (j >> 2)][j & 3]; const float hv = bf2f(f2bf(v)); hi[j] = hv; lo[j] = v - hv; }
            bhi[s] = __builtin_bit_cast(bf16x8, (v4u){pk2(hi[0], hi[1]), pk2(hi[2], hi[3]), pk2(hi[4], hi[5]), pk2(hi[6], hi[7])});
            blo[s] = __builtin_bit_cast(bf16x8, (v4u){pk2(lo[0], lo[1]), pk2(lo[2], lo[3]), pk2(lo[4], lo[5]), pk2(lo[6], lo[7])}); }
        asm volatile("s_waitcnt lgkmcnt(0)" ::: "memory");
#pragma unroll
        for (int m2 = 0; m2 < 4; ++m2) { f32x4 n = ht[m2];
#pragma unroll
            for (int s = 0; s < 2; ++s) { const bf16x8 af = __builtin_bit_cast(bf16x8, gfr[m2 * 2 + s]); n = __builtin_amdgcn_mfma_f32_16x16x32_bf16(af, bhi[s], n, 0, 0, 0); n = __builtin_amdgcn_mfma_f32_16x16x32_bf16(af, blo[s], n, 0, 0, 0); }
            S[m2] = n; }
        f32x4 yv[4];
#pragma unroll
        for (int mt = 0; mt < 4; ++mt) { f32x4 y = yl[mt];
#pragma unroll
            for (int s = 0; s < 2; ++s) { const bf16x8 af = __builtin_bit_cast(bf16x8, qfr[mt * 2 + s]); y = __builtin_amdgcn_mfma_f32_16x16x32_bf16(af, bhi[s], y, 0, 0, 0); }
            yv[mt] = y; }
#pragma unroll
        for (int i = 0; i < 2; ++i) YT[(size_t)c * 512 + i * 64] = (v4u){pk2(yv[2 * i][0], yv[2 * i][1]), pk2(yv[2 * i][2], yv[2 * i][3]), pk2(yv[2 * i + 1][0], yv[2 * i + 1][1]), pk2(yv[2 * i + 1][2], yv[2 * i + 1][3])};
    }
    asm volatile("s_waitcnt vmcnt(0)" ::: "memory");
#undef R3_ISSUE
}

__device__ __forceinline__ void p4b_rwkv_out(Frame& F, const Args& a) {
    const v4u* YT = (const v4u*)(a.ws + WS_YRAW); const bf16* BV = (const bf16*)(a.ws + WS_BV); const bf16* GG = (const bf16*)(a.ws + WS_GG); bf16* CAT = (bf16*)(a.ws + WS_CAT);
    const int gw = F.vcu * NWAVES + F.wave, NGW = F.G * NWAVES, fr = F.lane & 15, fq = F.lane >> 4;
    LAS float* tile = (LAS float*)(F.lds + F.wave * (16 * 68 * 4));
    const int tl = F.lane >> 2, qd = F.lane & 3;
    for (int item = gw; item < 64 * 64 * 4; item += NGW) { const int mt = item & 3, c = (item >> 2) & 63, bh = item >> 8, h = bh & 7, b = bh >> 3;
        f32x4 y[4];
#pragma unroll
        for (int vg = 0; vg < 4; ++vg) { const v4u w = YT[(((size_t)(bh * 64 + c) * 4 + vg) * 2 + (mt >> 1)) * 64 + F.lane]; const unsigned w0 = (mt & 1) ? w.z : w.x, w1 = (mt & 1) ? w.w : w.y;
            y[vg] = (f32x4){bf2f(w0 & 0xffffu), bf2f(w0 >> 16), bf2f(w1 & 0xffffu), bf2f(w1 >> 16)}; }
        const size_t tok = (size_t)b * SEQ + c * 64 + 16 * mt + tl;
        const v4u b0 = *(const v4u*)(BV + tok * 512 + h * 64 + 16 * qd), b1 = *(const v4u*)(BV + tok * 512 + h * 64 + 16 * qd + 8);
        const v4u g0 = *(const v4u*)(GG + tok * 512 + h * 64 + 16 * qd), g1 = *(const v4u*)(GG + tok * 512 + h * 64 + 16 * qd + 8);
#pragma unroll
        for (int vg = 0; vg < 4; ++vg)
#pragma unroll
            for (int rg = 0; rg < 4; ++rg) tile[(4 * fq + rg) * 68 + 16 * vg + fr] = y[vg][rg];
        LDS_WAIT(); asm volatile("" ::: "memory");
        f32x4 v[4];
#pragma unroll
        for (int j = 0; j < 4; ++j) v[j] = *(const LAS f32x4*)(tile + tl * 68 + 16 * qd + 4 * j);
        LDS_WAIT(); asm volatile("" ::: "memory");
        float s = 0.f;
#pragma unroll
        for (int j = 0; j < 4; ++j) s += (v[j][0] + v[j][1]) + (v[j][2] + v[j][3]);
        s = dpp_add<0x4E>(dpp_add<0xB1>(s));
        const float mean = s * (1.f / 64.f); float q = 0.f;
#pragma unroll
        for (int j = 0; j < 4; ++j) { v[j] = v[j] - mean; q += (v[j][0] * v[j][0] + v[j][1] * v[j][1]) + (v[j][2] * v[j][2] + v[j][3] * v[j][3]); }
        q = dpp_add<0x4E>(dpp_add<0xB1>(q));
        const float rstd = 1.f / sqrtf(q * (1.f / 64.f) + GN_EPS);
        const float* lw = INF32(15) + h * 64 + 16 * qd; const float* lb = INF32(16) + h * 64 + 16 * qd;
        float o[16];
#pragma unroll
        for (int j = 0; j < 4; ++j) { const f32x4 w4 = *(const f32x4*)(lw + 4 * j), bb4 = *(const f32x4*)(lb + 4 * j);
#pragma unroll
            for (int e = 0; e < 4; ++e) { const int ix = 4 * j + e; const float bvx = ix < 8 ? bfel(b0, ix) : bfel(b1, ix - 8), ggx = ix < 8 ? bfel(g0, ix) : bfel(g1, ix - 8);
                o[ix] = (v[j][e] * rstd * w4[e] + bb4[e] + bvx) * ggx; } }
        v4u* dst = (v4u*)(CAT + tok * 1024 + 512 + h * 64 + 16 * qd);
        dst[0] = (v4u){pk2(o[0], o[1]), pk2(o[2], o[3]), pk2(o[4], o[5]), pk2(o[6], o[7])}; dst[1] = (v4u){pk2(o[8], o[9]), pk2(o[10], o[11]), pk2(o[12], o[13]), pk2(o[14], o[15])};
    }
}
__device__ __forceinline__ void moe_table(Frame& F) {
    if (F.tid < 64) { const int e = F.lane & 31;
        const unsigned cnt = __hip_atomic_load(F.ctl + CW_CNT + 64 * e, __ATOMIC_RELAXED, __HIP_MEMORY_SCOPE_AGENT);
        const int tl = (int)((cnt + 255u) >> 8); int inc = tl;
#pragma unroll
        for (int o = 1; o < 32; o <<= 1) { const int up = __shfl_up(inc, o, 32); if (e >= o) inc += up; }
        if (F.lane < 32) { F.MISC[16 + e] = (unsigned)(inc - tl); if (e == 31) F.MISC[48] = (unsigned)inc; } }
    __syncthreads();
}
__device__ __forceinline__ void ln_stats(const f32x4 (&v)[4], float& mean, float& rstd) {
    float s = 0.f;
#pragma unroll
    for (int j = 0; j < 4; ++j) s += (v[j].x + v[j].y) + (v[j].z + v[j].w);
    mean = wave_sum_u(s) * (1.f / D); float s2 = 0.f;
#pragma unroll
    for (int j = 0; j < 4; ++j) { const f32x4 d = v[j] - mean; s2 += (d.x * d.x + d.y * d.y) + (d.z * d.z + d.w * d.w); }
    rstd = 1.f / sqrtf(wave_sum_u(s2) * (1.f / D) + LN_EPS);
}

constexpr int P6_HI = 0, P6_LO = 33024, P6_PART = 66048, P6_ASG = 82432, P6_HIST = 84480, P6_CURS = 84608, P6_BASE = 84736, P6_PAR = 86016;
struct P6Rows { f32x4 x[2][4]; v2u y[2][4]; };
struct P6Ctx { const float* x; const bf16* YMIX; const float* MOD; bf16* X1; unsigned char* H2; float* TOKG; const float* ln_g; const float* ln_b; const float* brt; int ntile; };
__device__ __forceinline__ void p6_load(P6Rows& R, const float* x, const bf16* YMIX, int tile, int w, int lane) {
#pragma unroll
    for (int t2 = 0; t2 < 2; ++t2) { const size_t tok = (size_t)16 * tile + 2 * w + t2; const f32x4* xr = (const f32x4*)(x + tok * D) + lane; const v2u* yr = (const v2u*)(YMIX + tok * D) + lane;
#pragma unroll
        for (int j = 0; j < 4; ++j) { R.x[t2][j] = xr[64 * j]; R.y[t2][j] = yr[64 * j]; } }
}
#define TOPSTEP(CTRL) { const float ov = __builtin_bit_cast(float, __builtin_amdgcn_update_dpp(0, __builtin_bit_cast(int, bv), CTRL, 0xf, 0xf, true)); const int oe = __builtin_amdgcn_update_dpp(0, be, CTRL, 0xf, 0xf, true); if (ov > bv || (ov == bv && oe < be)) { bv = ov; be = oe; } }
__device__ __forceinline__ bool p6_tile(Frame& F, const Args& a, const P6Ctx& C, P6Rows& RR, const bf16x8 (&bh)[2][4], float brt_e, int tile, int it) {
    LAS unsigned char* L = F.lds; LAS int* ASG = (LAS int*)(L + P6_ASG); LAS int* HIST = (LAS int*)(L + P6_HIST);
    const int fr = F.lane & 15, fq = F.lane >> 4, w = F.wave;
    const LAS f32x4* par = (const LAS f32x4*)(L + P6_PAR) + F.lane;
#pragma unroll
    for (int t2 = 0; t2 < 2; ++t2) { const int tl = 2 * w + t2, tok = 16 * tile + tl;
        f32x4 v[4];
#pragma unroll
        for (int j = 0; j < 4; ++j) { const v2u yv = RR.y[t2][j]; v[j] = RR.x[t2][j] * ALPHA + par[64 * j] * (f32x4){bf2f(yv.x & 0xffffu), bf2f(yv.x >> 16), bf2f(yv.y & 0xffffu), bf2f(yv.y >> 16)}; }
        float mean, rstd; ln_stats(v, mean, rstd);
        v2u* x1r = (v2u*)(C.X1 + (size_t)tok * D) + F.lane;
#pragma unroll
        for (int j = 0; j < 4; ++j) { v[j] = (v[j] - mean) * rstd * par[256 + 64 * j] + par[512 + 64 * j]; v2u xw; xw.x = pk2(v[j].x, v[j].y); xw.y = pk2(v[j].z, v[j].w); x1r[64 * j] = xw;
            v[j] = (f32x4){bf2f(xw.x & 0xffffu), bf2f(xw.x >> 16), bf2f(xw.y & 0xffffu), bf2f(xw.y >> 16)}; }
        ln_stats(v, mean, rstd);
        unsigned* h2r = (unsigned*)(C.H2 + (size_t)tok * D) + F.lane;
#pragma unroll
        for (int j = 0; j < 4; ++j) { const f32x4 hv = (v[j] - mean) * rstd * par[1024 + 64 * j] + par[768 + 64 * j];
            v2u hi; hi.x = pk2(hv.x, hv.y); hi.y = pk2(hv.z, hv.w); h2r[64 * j] = pg8::pk4_fp8(hv.x, hv.y, hv.z, hv.w);
            const float r0 = hv.x - bf2f(hi.x & 0xffffu), r1 = hv.y - bf2f(hi.x >> 16), r2 = hv.z - bf2f(hi.y & 0xffffu), r3 = hv.w - bf2f(hi.y >> 16);
            v2u lo; lo.x = pk2(r0, r1); lo.y = pk2(r2, r3);
            *(LAS v2u*)(L + P6_HI + tl * 2064 + (4 * F.lane + 256 * j) * 2) = hi; *(LAS v2u*)(L + P6_LO + tl * 2064 + (4 * F.lane + 256 * j) * 2) = lo; }
    }
    if (it + 2 < 8) p6_load(RR, C.x, C.YMIX, (tile & ~7) + ((tile + 2) & 7), w, F.lane);
    __syncthreads();
    if (a.pad == 6) return false;
    {   f32x4 acc[2] = {(f32x4){0.f, 0.f, 0.f, 0.f}, (f32x4){0.f, 0.f, 0.f, 0.f}};
#pragma unroll
        for (int s = 0; s < 4; ++s) { const bf16x8 ah = *(const LAS bf16x8*)(L + P6_HI + fr * 2064 + (128 * w + 32 * s + 8 * fq) * 2), al = *(const LAS bf16x8*)(L + P6_LO + fr * 2064 + (128 * w + 32 * s + 8 * fq) * 2);
#pragma unroll
            for (int nt = 0; nt < 2; ++nt) { acc[nt] = __builtin_amdgcn_mfma_f32_16x16x32_bf16(ah, bh[nt][s], acc[nt], 0, 0, 0); acc[nt] = __builtin_amdgcn_mfma_f32_16x16x32_bf16(al, bh[nt][s], acc[nt], 0, 0, 0); } }
#pragma unroll
        for (int nt = 0; nt < 2; ++nt)
#pragma unroll
            for (int rg = 0; rg < 4; ++rg) *(LAS float*)(L + P6_PART + ((w * 16 + 4 * fq + rg) * 32 + 16 * nt + fr) * 4) = acc[nt][rg]; }
    __syncthreads();
    {   const int tl = F.tid >> 5, e = F.tid & 31, tok = 16 * tile + tl;
        float v = brt_e;
#pragma unroll
        for (int w2 = 0; w2 < 8; ++w2) v += *(const LAS float*)(L + P6_PART + ((w2 * 16 + tl) * 32 + e) * 4);
        float sv[4]; int se[4];
#pragma unroll
        for (int r = 0; r < 4; ++r) { float bv = v; int be = e;
            TOPSTEP(0xB1) TOPSTEP(0x4E) TOPSTEP(0x141) TOPSTEP(0x140)
            { const float ov = __shfl_xor(bv, 16); const int oe = __shfl_xor(be, 16); if (ov > bv || (ov == bv && oe < be)) { bv = ov; be = oe; } }
            sv[r] = bv; se[r] = be; if (e == be) v = -3.0e38f; }
        if (e == 0 && a.pad < 5) { const float e1 = __expf(sv[1] - sv[0]), e2 = __expf(sv[2] - sv[0]), e3 = __expf(sv[3] - sv[0]); const float inv = 1.0f / (1.0f + e1 + e2 + e3);
            *(f32x4*)(C.TOKG + (size_t)tok * 4) = (f32x4){inv, e1 * inv, e2 * inv, e3 * inv};
#pragma unroll
            for (int r = 0; r < 4; ++r) { ASG[(it * 16 + tl) * 4 + r] = se[r]; __hip_atomic_fetch_add(&HIST[se[r]], 1, __ATOMIC_RELAXED, __HIP_MEMORY_SCOPE_WORKGROUP); } } }
    return true;
}
#undef TOPSTEP
__device__ __forceinline__ void p6_route(Frame& F, const Args& a) {
    P6Ctx C; C.x = INF32(0); C.YMIX = (const bf16*)(a.ws + WS_YMIX); C.MOD = (const float*)(a.ws + WS_MOD); C.X1 = (bf16*)(a.ws + WS_X1); C.H2 = a.ws + WS_H2; C.TOKG = (float*)(a.ws + WS_TOKG);
    C.ln_g = INF32(19); C.ln_b = INF32(20); C.brt = INF32(22); C.ntile = T / 16;
    int* TOKE = (int*)(a.ws + WS_TOKE);
    LAS unsigned char* L = F.lds;
    LAS int* ASG = (LAS int*)(L + P6_ASG); LAS int* HIST = (LAS int*)(L + P6_HIST); LAS int* CURS = (LAS int*)(L + P6_CURS); LAS int* BASE = (LAS int*)(L + P6_BASE);
    const int fr = F.lane & 15, fq = F.lane >> 4, w = F.wave;
    if (F.tid < 32) { HIST[F.tid] = 0; CURS[F.tid] = 0; }
    { int* SMAP = (int*)(a.ws + WS_SMAP); for (int i = blockIdx.x * NTHR + F.tid; i < ROWS_PAD; i += F.G * NTHR) SMAP[i] = -1; }
    static_assert(T / 16 == 8 * 256, "eight consecutive 16-token tiles per workgroup");
    const int tile0 = 8 * F.vcu, bb = (16 * tile0) >> 12;
    const int rot = F.vcu & 7;
    P6Rows RA, RB; p6_load(RA, C.x, C.YMIX, tile0 + rot, w, F.lane); p6_load(RB, C.x, C.YMIX, tile0 + ((rot + 1) & 7), w, F.lane);
    for (int i = F.tid; i < 5 * 256; i += NTHR) { const int vsel = i >> 8, q4 = i & 255;
        const float* src = vsel == 0 ? C.MOD + bb * 6144 + 2048 : (vsel == 1 ? C.ln_g : (vsel == 2 ? C.ln_b : (vsel == 3 ? C.MOD + bb * 6144 + 3072 : C.MOD + bb * 6144 + 4096)));
        *((LAS f32x4*)(L + P6_PAR) + i) = *((const f32x4*)src + q4); }
    const float brt_e = C.brt[F.tid & 31];
    bf16x8 bh[2][4];
    {   const float* wr = INF32(21);
#pragma unroll
        for (int nt = 0; nt < 2; ++nt)
#pragma unroll
            for (int s = 0; s < 4; ++s) { float hi[8];
#pragma unroll
                for (int j = 0; j < 8; ++j) hi[j] = wr[(size_t)(128 * w + 32 * s + 8 * fq + j) * 32 + 16 * nt + fr];
                bh[nt][s] = __builtin_bit_cast(bf16x8, (v4u){pk2(hi[0], hi[1]), pk2(hi[2], hi[3]), pk2(hi[4], hi[5]), pk2(hi[6], hi[7])}); } }
    __syncthreads();
    int it = 0;
#pragma unroll 1
    for (; it < 8; ) {
        if (!p6_tile(F, a, C, RA, bh, brt_e, tile0 + ((it + rot) & 7), it)) return; ++it; __builtin_amdgcn_sched_barrier(0);
        if (!p6_tile(F, a, C, RB, bh, brt_e, tile0 + ((it + rot) & 7), it)) return; ++it; __builtin_amdgcn_sched_barrier(0); }
    __syncthreads();
    if (a.pad >= 5) return;
    if (F.tid < 32) BASE[F.tid] = (int)__hip_atomic_fetch_add(F.ctl + CW_CNT + 64 * F.tid, (unsigned)HIST[F.tid], __ATOMIC_RELAXED, __HIP_MEMORY_SCOPE_AGENT);
    __syncthreads();
    {   const int ai = F.tid, nasg = it * 64;
        if (ai < nasg) { const int e = ASG[ai]; const int idx = BASE[e] + __hip_atomic_fetch_add(&CURS[e], 1, __ATOMIC_RELAXED, __HIP_MEMORY_SCOPE_WORKGROUP);
            const int i2 = ai >> 6, tl = (ai >> 2) & 15, k = ai & 3, tok = 16 * (8 * F.vcu + ((i2 + rot) & 7)) + tl;
            TOKE[(size_t)tok * 4 + k] = (e << 16) | idx; ((int*)(a.ws + WS_STOK))[e * 32768 + idx] = tok; } }
    __syncthreads();
}

__device__ __forceinline__ void p6b_scatter(Frame& F, const Args& a) {
    moe_table(F);
    const unsigned char* H2 = a.ws + WS_H2; unsigned char* XS = a.ws + WS_XS; const int* TOKE = (const int*)(a.ws + WS_TOKE); int* SMAP = (int*)(a.ws + WS_SMAP);
    const int gw = F.vcu * NWAVES + F.wave, NGW = F.G * NWAVES;
    for (int tok = gw; tok < T; tok += NGW) {
        const v4u r0 = *((const v4u*)(H2 + (size_t)tok * D) + F.lane);
#pragma unroll
        for (int k = 0; k < 4; ++k) { const int ei = TOKE[(size_t)tok * 4 + k]; const int e = ei >> 16, idx = ei & 0xffff; const size_t slot = (size_t)256 * F.MISC[16 + e] + idx;
            *((v4u*)(XS + slot * D) + F.lane) = r0; if (F.lane == 0) SMAP[slot] = tok * 4 + k; }
    }
}

typedef int i32x4 __attribute__((ext_vector_type(4)));
struct P9Rows { unsigned y[4][4]; v2u x1[4]; f32x4 gk; };
struct P9Ctx { const bf16* X1; const unsigned char* YB; const float* MOD; const int* TOKE; const float* TOKG; const float* g2; const float* b2; float* out; int dry; };
__device__ __forceinline__ void p9_rows(P9Rows& R, const Frame& F, const P9Ctx& C, int tok) {
    R.gk = *(const f32x4*)(C.TOKG + (size_t)tok * 4);
    const v2u* x1r = (const v2u*)(C.X1 + (size_t)tok * D) + F.lane;
#pragma unroll
    for (int j = 0; j < 4; ++j) R.x1[j] = x1r[64 * j];
#pragma unroll
    for (int k = 0; k < 4; ++k) { const unsigned* yr = (const unsigned*)(C.YB + ((size_t)tok * 4 + k) * D) + F.lane;
#pragma unroll
        for (int j = 0; j < 4; ++j) R.y[k][j] = yr[64 * j]; }
}
__device__ __forceinline__ f32x4 fp84(const unsigned w) { const f32x2 lo = __builtin_amdgcn_cvt_pk_f32_fp8((int)w, false), hi = __builtin_amdgcn_cvt_pk_f32_fp8((int)w, true); return (f32x4){lo[0], lo[1], hi[0], hi[1]}; }
__device__ __forceinline__ f32x4 bf4(const v2u w) { return (f32x4){bf2f(w.x & 0xffffu), bf2f(w.x >> 16), bf2f(w.y & 0xffffu), bf2f(w.y >> 16)}; }
__device__ __forceinline__ void p9_token(const Frame& F, const P9Ctx& C, P9Rows& R, int tok0, int o, int rot, int& nbad) {
    const int tok = tok0 + ((o + rot) & 15);
    const LAS f32x4* par = (const LAS f32x4*)F.lds + F.lane;
    f32x4 acc[4];
#pragma unroll
    for (int j = 0; j < 4; ++j) acc[j] = (fp84(R.y[0][j]) * R.gk[0] + fp84(R.y[1][j]) * R.gk[1] + fp84(R.y[2][j]) * R.gk[2] + fp84(R.y[3][j]) * R.gk[3]) * 0.0625f;
    f32x4 v[4];
#pragma unroll
    for (int j = 0; j < 4; ++j) v[j] = bf4(R.x1[j]) * ALPHA + par[64 * j] * acc[j];
    if (o + 2 < 16) p9_rows(R, F, C, tok0 + ((o + 2 + rot) & 15));
    float mean, rstd; ln_stats(v, mean, rstd);
    f32x4* orow = (f32x4*)(C.out + (size_t)tok * D) + F.lane;
#pragma unroll
    for (int j = 0; j < 4; ++j) { f32x4 o = (v[j] - mean) * rstd * par[256 + 64 * j] + par[512 + 64 * j];
#if MK_DEBUG
#pragma unroll
        for (int q = 0; q < 4; ++q) if (!(fabsf(o[q]) < 1e30f)) { o[q] = 0.f; ++nbad; }
#endif
        if (C.dry != 9) orow[64 * j] = o; else if (o[0] == 123.456f) orow[64 * j] = o; }
}
__device__ __forceinline__ void p9_final(Frame& F, const Args& a) {
    P9Ctx C; C.X1 = (const bf16*)(a.ws + WS_X1); C.YB = a.ws + WS_YB; C.MOD = (const float*)(a.ws + WS_MOD); C.TOKE = (const int*)(a.ws + WS_TOKE); C.TOKG = (const float*)(a.ws + WS_TOKG);
    C.g2 = INF32(27); C.b2 = INF32(28); C.out = a.out; C.dry = a.pad;
    static_assert(T == 256 * NWAVES * 16, "sixteen consecutive tokens per wave");
    const int gw = F.vcu * NWAVES + F.wave, tok0 = 16 * gw, bb = tok0 >> 12; int nbad = 0; (void)nbad;
    const int rot = gw & 15;
    P9Rows RA, RB; p9_rows(RA, F, C, tok0 + rot); p9_rows(RB, F, C, tok0 + ((1 + rot) & 15));
    for (int i = F.tid; i < 3 * 256; i += NTHR) { const int vsel = i >> 8, q4 = i & 255; const float* src = vsel == 0 ? C.MOD + bb * 6144 + 5120 : (vsel == 1 ? C.g2 : C.b2); *((LAS f32x4*)F.lds + i) = *((const f32x4*)src + q4); }
    __syncthreads();
#pragma unroll 1
    for (int o = 0; o < 16; o += 2) { p9_token(F, C, RA, tok0, o, rot, nbad); __builtin_amdgcn_sched_barrier(0); p9_token(F, C, RB, tok0, o + 1, rot, nbad); __builtin_amdgcn_sched_barrier(0); }
#if MK_DEBUG
    { float nb = wave_sum((float)nbad); if (F.lane == 0 && nb > 0.f) atomicAdd(F.ctl + 16, (unsigned)nb); }
#endif
}

#ifndef MK_DEBUG
#define MK_DEBUG 0
#endif
#ifndef MK_PROBE
#define MK_PROBE 0
#endif
#ifndef MK_LASTPH
#define MK_LASTPH 12
#endif
constexpr int NPHASE = (MK_DEBUG || MK_PROBE) ? 13 : 12;
__global__ void __launch_bounds__(NTHR, 2) mk_fwd(Args a) {
    extern __shared__ __attribute__((aligned(16))) unsigned char lds[];
    Frame F;
    F.lds = (LAS unsigned char*)lds;
    F.MISC = (volatile LAS unsigned*)(F.lds + MISC_OFF);
    F.tid = threadIdx.x; F.lane = F.tid & 63; F.wave = __builtin_amdgcn_readfirstlane(F.tid >> 6);
    F.G = gridDim.x; { const int bx = blockIdx.x; F.vcu = (F.G % 8 == 0) ? (bx % 8) * (F.G / 8) + bx / 8 : bx; }
    F.ctl = (unsigned*)(a.ws + WS_CTL);
    for (int u = F.tid; u < 64; u += NTHR) F.MISC[u] = 0u;
    __syncthreads();
    XcdBarrier bar; bar.bar = F.ctl + CW_BAR + a.li * XCD_BAR_WORDS; bar.x = 0; bar.st = nullptr;
#if !MK_PER_PHASE
    bar = xcd_barrier_post(F.ctl + CW_BAR + a.li * XCD_BAR_WORDS, F.MISC + 8);
#define GRID_BAR() xcd_barrier(bar)
#else
#define GRID_BAR() do {} while (0)
#endif
    const int lo = a.ph_lo, hi = a.ph_hi;
#ifndef PHASE_MASK
#define PHASE_MASK 0xFFF
#endif
#define IN(k) (((PHASE_MASK >> (k)) & 1) && lo <= (k) && (k) < hi)
#define SEAM(k) do { if (IN(k) && IN((k) + 1)) GRID_BAR(); } while (0)
    unsigned char* ws = a.ws;
    using namespace pg8;
    if (IN(0)) { p0_prologue(F, a); } SEAM(0);
    if (IN(1)) { p1_h1(F, a); } SEAM(1);
    if (IN(2)) {
        Gemm g{(const bf16_t*)(ws + WS_H1), (const bf16_t*)(ws + WS_WIN), 1024, 0}; StaticOrder S; S.init(T, DINP, F.G, (int)blockIdx.x);
        EpiBf16 E{(bf16_t*)(ws + WS_PROJ), DINP, nullptr, 0};
        gemm_phase<EpiBf16, StaticOrder, true, true>(F.lds, g, S, E);
    } SEAM(2);
    if (IN(3)) {
        if (a.pad != 2) for (int u = F.vcu; u < 512; u += F.G) attn_unit(F, a, u);
        if (a.pad != 1) {
            static_assert(NB * 64 == 2 * 256, "two (batch, chunk) pairs per workgroup");
            R2Raw R; v4u lin[3] = {(v4u){0u, 0u, 0u, 0u}, (v4u){0u, 0u, 0u, 0u}, (v4u){0u, 0u, 0u, 0u}};
#define R2_CH(i) ((((2 * F.vcu + ((i) >> 3)) >> 6) * 8 + ((i) & 7)) * 64 + ((2 * F.vcu + ((i) >> 3)) & 63))
            r2_load(R, F, a, R2_CH(0), true);
#pragma unroll 1
            for (int i = 0; i < 16; ++i) r2_unit(F, a, R2_CH(i), R, i + 1 < 16 ? R2_CH(i + 1) : -1, ((i + 1) & 7) == 0, (i & 7) == 0, lin);
#undef R2_CH
        }
    } SEAM(3);
    if (IN(4)) { r3_scan(F, a); } SEAM(4);
    if (IN(5)) { p4b_rwkv_out(F, a); } SEAM(5);
    if (IN(6)) {
        Gemm g{(const bf16_t*)(ws + WS_CAT), (const bf16_t*)(ws + WS_WOUT), 1024, 0}; StaticOrder S; S.init(T, 1024, F.G, (int)blockIdx.x);
        EpiBf16 E{(bf16_t*)(ws + WS_YMIX), 1024, nullptr, 0};
        gemm_phase<EpiBf16, StaticOrder, true, true>(F.lds, g, S, E);
    } SEAM(6);
    if (IN(7)) { p6_route(F, a); } SEAM(7);
    if (IN(9)) {
        moe_table(F);
        {
            const int* TOKE = (const int*)(ws + WS_TOKE); int* SMAP = (int*)(ws + WS_SMAP);
            for (int i = blockIdx.x * NTHR + F.tid; i < T * 4; i += F.G * NTHR) { const int ei = TOKE[i]; SMAP[256 * (int)F.MISC[16 + (ei >> 16)] + (ei & 0xffff)] = i; } }
        MoeOrder S{(const LAS int*)(F.lds + MISC_OFF + 64), 8, F.G, F.vcu};
        LAS unsigned short* tl = (LAS unsigned short*)(F.lds + 131072);
        {   const int* STOK = (const int*)(ws + WS_STOK); pg8::Unit u;
            for (int ui = 0; ui < 17 && S.next(ui, u); ++ui) { const int r = F.tid & 255; if ((F.tid >> 8) != (ui & 1)) continue;
                const int idx = 256 * (u.pm - (int)F.MISC[16 + u.e]) + r; const int cnt = (int)__hip_atomic_load(F.ctl + CW_CNT + 64 * u.e, __ATOMIC_RELAXED, __HIP_MEMORY_SCOPE_AGENT);
                tl[ui * 256 + r] = (unsigned short)(idx < cnt ? STOK[u.e * 32768 + idx] : 0); } }
        __syncthreads();
        Gemm g{(const bf16_t*)(ws + WS_H2), (const bf16_t*)(ws + WS_WGU), 512, (size_t)2048 * 1024, 0x7F7F7F7F, 0x7A7A7A7A, a.pad, tl};
        EpiSwiglu8 E{ws + WS_ACT, INF32(24)};
        gemm_phase<EpiSwiglu8, MoeOrder, true, true, true, true>(F.lds, g, S, E);
    } SEAM(9);
    if (IN(10)) {
        moe_table(F);
        Gemm g{(const bf16_t*)(ws + WS_ACT), (const bf16_t*)(ws + WS_WDN), 512, (size_t)1024 * 1024, 0x7F7F7F7F, 0x7A7A7A7A, a.pad}; MoeOrder S{(const LAS int*)(F.lds + MISC_OFF + 64), 4, F.G, F.vcu};
        EpiScatter E{ws + WS_YB, INF32(26), (const int*)(ws + WS_SMAP)};
        gemm_phase<EpiScatter, MoeOrder, true, true, true>(F.lds, g, S, E);
    } SEAM(10);
    if (IN(11)) { p9_final(F, a); } SEAM(11);
#if MK_PROBE
    if (lo <= 12 && 12 < hi) {
        const size_t n = (size_t)T * D; const size_t i0 = (size_t)blockIdx.x * NTHR + F.tid, st = (size_t)F.G * NTHR;
        const bf16* H1 = (const bf16*)(ws + WS_H1); const bf16* PROJ = (const bf16*)(ws + WS_PROJ); const bf16* CAT = (const bf16*)(ws + WS_CAT); const bf16* BV = (const bf16*)(ws + WS_BV); const bf16* GG = (const bf16*)(ws + WS_GG);
        const float* HT = (const float*)(ws + WS_HT); const float* YL = (const float*)(ws + WS_YL); const bf16* GF = (const bf16*)(ws + WS_GF); const bf16* QF = (const bf16*)(ws + WS_QF);
        const float* YRAW = (const float*)(ws + WS_YRAW); const bf16* YMIXb = (const bf16*)(ws + WS_YMIX); const bf16* X1 = (const bf16*)(ws + WS_X1); const unsigned char* H2 = ws + WS_H2;
        const float* TOKG = (const float*)(ws + WS_TOKG); const int* TOKE = (const int*)(ws + WS_TOKE);
        for (size_t i = i0; i < n; i += st) { const size_t tok = i >> 10; const int k = (int)(i & 1023); float v = 0.f;
            if (MK_PROBE == 1) v = bf2f(H1[i]);
            if (MK_PROBE == 2) v = bf2f(PROJ[tok * DINP + k]) + bf2f(PROJ[tok * DINP + 1024 + k]) + bf2f(PROJ[tok * DINP + (k + 2048 < DIN ? k + 2048 : DIN - 1)]);
            if (MK_PROBE == 3) v = k < 512 ? bf2f(CAT[tok * 1024 + k]) : bf2f(BV[tok * 512 + k - 512]) + bf2f(GG[tok * 512 + k - 512]);
            if (MK_PROBE == 4) { const size_t h = n >> 1; v = bf2f(GF[i % h]) + bf2f(QF[i % h]); }
            if (MK_PROBE == 5) v = YRAW[i >> 2];
            if (MK_PROBE == 6) v = bf2f(CAT[i]);
            if (MK_PROBE == 7) v = bf2f(YMIXb[i]);
            if (MK_PROBE == 8) v = bf2f(X1[i]) + (float)H2[i] + TOKG[tok * 4 + (k & 3)] + (float)(TOKE[tok * 4 + (k & 3)] >> 16);
            if (MK_PROBE == 9) v = k < 512 ? bf2f(CAT[tok * 1024 + k]) : 0.f;
            if (MK_PROBE == 10) v = k < 512 ? bf2f(BV[tok * 512 + k]) : 0.f;
            if (MK_PROBE == 11) v = k < 512 ? bf2f(GG[tok * 512 + k]) : 0.f;
            if (!(fabsf(v) < 1e30f)) v = 12345.f;
            a.out[i] = v; }
    }
#elif MK_DEBUG
    if (lo <= 12 && 12 < hi) { if (blockIdx.x == 0 && F.tid == 0) { const unsigned nb = __hip_atomic_load(F.ctl + 16, __ATOMIC_RELAXED, __HIP_MEMORY_SCOPE_AGENT); if (nb) a.out[0] = 1.0e4f * sqrtf((float)nb); } }
#endif
#undef IN
#undef SEAM
}

extern "C" void kernel_launch(void* const* d_in, const int* in_sizes, int n_in, void* d_out, int out_size, void* d_ws, size_t ws_size, hipStream_t stream) {
    static int grid = 0;
    if (grid == 0) {
        if (n_in != 29 || in_sizes[0] != T * D || out_size != T * D || ws_size < WS_END) { fprintf(stderr, "kernel_launch: unexpected shapes (n_in %d, in0 %d, out %d, ws %zu < %zu); nothing launched\n", n_in, n_in > 0 ? in_sizes[0] : -1, out_size, ws_size, (size_t)WS_END); grid = -1; return; }
        int dev = 0, cus = 0, per_cu = 0;
        if (hipGetDevice(&dev) != hipSuccess || hipDeviceGetAttribute(&cus, hipDeviceAttributeMultiprocessorCount, dev) != hipSuccess) { grid = -1; return; }
        if (hipFuncSetAttribute((const void*)mk_fwd, hipFuncAttributeMaxDynamicSharedMemorySize, LDS_BYTES) != hipSuccess) { fprintf(stderr, "kernel_launch: hipFuncSetAttribute failed\n"); grid = -1; return; }
        if (hipOccupancyMaxActiveBlocksPerMultiprocessor(&per_cu, (const void*)mk_fwd, NTHR, LDS_BYTES) != hipSuccess || per_cu < 1) fprintf(stderr, "kernel_launch: occupancy query reports %d\n", per_cu);
        (void)hipGetLastError();
        grid = cus < 256 ? cus : 256;
    }
    if (grid < 0) return;
    if (hipMemsetAsync((char*)d_ws + WS_CTL, 0, CTL_ZERO_BYTES, stream) != hipSuccess) { fprintf(stderr, "kernel_launch: memset failed\n"); return; }
    Args a{};
    for (int i = 0; i < 29; ++i) a.in[i] = d_in[i];
    a.out = (float*)d_out; a.ws = (unsigned char*)d_ws;
#if MK_PER_PHASE
    for (int p = 0; p < NPHASE; ++p) { if (p >= MK_LASTPH && p != 12) continue; a.ph_lo = p; a.ph_hi = p + 1; hipLaunchKernelGGL(mk_fwd, dim3(grid), dim3(NTHR), LDS_BYTES, stream, a); }
#else
#if defined(TIME_PHASE)
    a.ph_lo = 0; a.ph_hi = TIME_PHASE + 1; a.li = 0; hipLaunchKernelGGL(mk_fwd, dim3(grid), dim3(NTHR), LDS_BYTES, stream, a);
    a.ph_lo = TIME_PHASE; a.ph_hi = TIME_PHASE + 1; a.li = 1;
#ifdef TIME_SUB
    a.pad = TIME_SUB;
#endif
    hipLaunchKernelGGL(mk_fwd, dim3(grid), dim3(NTHR), LDS_BYTES, stream, a); a.pad = 0;
    if (TIME_PHASE + 1 < NPHASE) { a.ph_lo = TIME_PHASE + 1; a.ph_hi = NPHASE; a.li = 2; hipLaunchKernelGGL(mk_fwd, dim3(grid), dim3(NTHR), LDS_BYTES, stream, a); }
#else
    a.ph_lo = 0; a.ph_hi = NPHASE; hipLaunchKernelGGL(mk_fwd, dim3(grid), dim3(NTHR), LDS_BYTES, stream, a);
#endif
#endif
}
```
